# Optimizing an MI355X kernel written in HIP

```python
import math
import numpy as np
import jax
import jax.numpy as jnp
from jax import lax

D_MODEL = 2048
BATCH = 4
SEQ = 2048
DEPTH = 2

HEAD_DIM = 64
N_BRANCH = 4
MIX_HEADS = D_MODEL // (N_BRANCH * HEAD_DIM)
BRANCH_WIDTH = MIX_HEADS * HEAD_DIM
Q_BLOCK = 128
ROPE_THETA = 500000.0
PARTIAL_ROT = HEAD_DIM // 4
RMS_EPS = 1e-6
NEG = -1e30

MLA_Q_LORA = D_MODEL // 4
MLA_KV_LORA = D_MODEL // 8
MLA_NOPE = HEAD_DIM
MLA_ROPE = HEAD_DIM // 2
MLA_V = HEAD_DIM

NSA_KV_HEADS = 2
NSA_KV_WIDTH = NSA_KV_HEADS * HEAD_DIM
NSA_CMP_LEN = 32
NSA_CMP_STRIDE = 16
NSA_CMP_HIDDEN = 256
NSA_SEL_LEN = 64
NSA_SEL_TOP = 16
NSA_WINDOW = 512
NSA_FORCE_BONUS = 1e3

PEER_HEADS = 8
PEER_KEYS = 128
PEER_EXPERTS = PEER_KEYS * PEER_KEYS
PEER_TOPK = 16
PEER_QDIM = 256
PEER_CHUNK = 128

IN_SPLITS = (
    BRANCH_WIDTH, BRANCH_WIDTH, BRANCH_WIDTH, MIX_HEADS,
    MLA_Q_LORA, MLA_KV_LORA, MLA_ROPE,
    BRANCH_WIDTH, NSA_KV_WIDTH, NSA_KV_WIDTH, NSA_KV_WIDTH,
    NSA_KV_WIDTH, NSA_KV_WIDTH, NSA_KV_WIDTH, 3 * MIX_HEADS,
    BRANCH_WIDTH, BRANCH_WIDTH, BRANCH_WIDTH,
    N_BRANCH * D_MODEL,
)
IN_WIDTH = sum(IN_SPLITS)

kernel_name = 'hybrid_fox_mla_nsa_stickbreak_peer'


def rms_norm(x, g):
    xf = x.astype(jnp.float32)
    y = xf * lax.rsqrt(jnp.mean(xf * xf, axis=-1, keepdims=True) + RMS_EPS)
    return (y * g.astype(jnp.float32)).astype(x.dtype)


def rope(x, pos, rot_dim):
    half = rot_dim // 2
    inv = jnp.exp(-math.log(ROPE_THETA) * jnp.arange(half, dtype=jnp.float32) / half)
    ang = pos.astype(jnp.float32)[:, None] * inv[None, :]
    cos = jnp.cos(ang)[:, None, :]
    sin = jnp.sin(ang)[:, None, :]
    xr = x[..., :rot_dim].astype(jnp.float32)
    x1, x2 = xr[..., :half], xr[..., half:]
    rot = jnp.concatenate([x1 * cos - x2 * sin, x1 * sin + x2 * cos], axis=-1)
    return jnp.concatenate([rot.astype(x.dtype), x[..., rot_dim:]], axis=-1)


def heads(t, n):
    return t.reshape(t.shape[:-1] + (n, -1))


def sweep_query_blocks(fn, S):
    out = lax.map(fn, jnp.arange(S // Q_BLOCK) * Q_BLOCK)
    out = jnp.moveaxis(out, 0, 1)
    return out.reshape((out.shape[0], S) + out.shape[3:])


def fox_attention(q, k, v, log_f):
    B, S, H, Dh = q.shape
    F = jnp.swapaxes(jnp.cumsum(log_f, axis=1), 1, 2)
    scale = Dh ** -0.5
    kpos = jnp.arange(S)

    def block(start):
        qb = lax.dynamic_slice_in_dim(q, start, Q_BLOCK, 1)
        Fq = lax.dynamic_slice_in_dim(F, start, Q_BLOCK, 2)
        s = jnp.einsum('bqhd,bkhd->bhqk', qb, k, preferred_element_type=jnp.float32) * scale
        s = s + Fq[..., :, None] - F[..., None, :]
        qpos = start + jnp.arange(Q_BLOCK)
        mask = kpos[None, :] <= qpos[:, None]
        p = jax.nn.softmax(jnp.where(mask, s, NEG), axis=-1)
        return jnp.einsum('bhqk,bkhd->bqhd', p.astype(v.dtype), v)

    return sweep_query_blocks(block, S)


def mla_attention(c_q, c_kv, k_r, g_q, g_kv, w_uq, w_ukv, pos):
    B, S, _ = c_q.shape
    q = (rms_norm(c_q, g_q) @ w_uq).reshape(B, S, MIX_HEADS, MLA_NOPE + MLA_ROPE)
    kv = (rms_norm(c_kv, g_kv) @ w_ukv).reshape(B, S, MIX_HEADS, MLA_NOPE + MLA_V)
    q_nope = q[..., :MLA_NOPE]
    q_rope = rope(q[..., MLA_NOPE:], pos, MLA_ROPE)
    k_nope, v = kv[..., :MLA_NOPE], kv[..., MLA_NOPE:]
    k_rope = rope(k_r[:, :, None, :], pos, MLA_ROPE)[:, :, 0]
    scale = (MLA_NOPE + MLA_ROPE) ** -0.5
    kpos = jnp.arange(S)

    def block(start):
        qn = lax.dynamic_slice_in_dim(q_nope, start, Q_BLOCK, 1)
        qr = lax.dynamic_slice_in_dim(q_rope, start, Q_BLOCK, 1)
        s = (jnp.einsum('bqhd,bkhd->bhqk', qn, k_nope, preferred_element_type=jnp.float32)
             + jnp.einsum('bqhd,bkd->bhqk', qr, k_rope, preferred_element_type=jnp.float32)) * scale
        qpos = start + jnp.arange(Q_BLOCK)
        mask = kpos[None, :] <= qpos[:, None]
        p = jax.nn.softmax(jnp.where(mask, s, NEG), axis=-1)
        return jnp.einsum('bhqk,bkhd->bqhd', p.astype(v.dtype), v)

    return sweep_query_blocks(block, S)


def compress_blocks(t, tok_idx, pos_emb, w1, w2):
    B, S, G, Dh = t.shape
    n_cmp, L = tok_idx.shape
    blocks = jnp.take(t, tok_idx, axis=1) + pos_emb[:, None, :]
    blocks = jnp.swapaxes(blocks, 2, 3).reshape(B, n_cmp, G, L * Dh)
    return jax.nn.gelu(blocks @ w1, approximate=False) @ w2


def nsa_attention(q, k_c, v_c, k_s, v_s, k_w, v_w, gates, pos,
                  kc_pos, kc_w1, kc_w2, vc_pos, vc_w1, vc_w2):
    B, S, H, Dh = q.shape
    G = k_c.shape[2]
    R = H // G
    scale = Dh ** -0.5
    q = rope(q, pos, PARTIAL_ROT)
    k_s = rope(k_s, pos, PARTIAL_ROT)
    k_w = rope(k_w, pos, PARTIAL_ROT)
    qg = q.reshape(B, S, G, R, Dh)

    n_cmp = (S - NSA_CMP_LEN) // NSA_CMP_STRIDE + 1
    cmp_start = jnp.arange(n_cmp) * NSA_CMP_STRIDE
    tok_idx = cmp_start[:, None] + jnp.arange(NSA_CMP_LEN)[None, :]
    cmp_end = cmp_start + NSA_CMP_LEN - 1
    kc = rope(compress_blocks(k_c, tok_idx, kc_pos, kc_w1, kc_w2), cmp_end, PARTIAL_ROT)
    vc = compress_blocks(v_c, tok_idx, vc_pos, vc_w1, vc_w2)
    s = jnp.einsum('bsgrd,bcgd->bgrsc', qg, kc, preferred_element_type=jnp.float32) * scale
    cmask = cmp_end[None, :] <= pos[:, None]
    p_cmp = jax.nn.softmax(jnp.where(cmask, s, NEG), axis=-1) * cmask
    o_cmp = jnp.einsum('bgrsc,bcgd->bsgrd', p_cmp.astype(vc.dtype), vc).reshape(B, S, H, Dh)

    n_sel = S // NSA_SEL_LEN
    sel_lo = jnp.arange(n_sel) * NSA_SEL_LEN
    cover = jnp.clip(jnp.minimum(cmp_start[:, None] + NSA_CMP_LEN, sel_lo[None, :] + NSA_SEL_LEN)
                     - jnp.maximum(cmp_start[:, None], sel_lo[None, :]), 0, None)
    cmp_to_sel = cover.astype(jnp.float32) / NSA_CMP_LEN
    imp = jnp.einsum('bgrsc,cj->bsgj', p_cmp, cmp_to_sel)
    blk = jnp.arange(n_sel)[None, :]
    cur = (pos // NSA_SEL_LEN)[:, None]
    forced = ((blk == 0) | (blk == cur) | (blk == cur - 1)).astype(jnp.float32)
    valid = blk * NSA_SEL_LEN <= pos[:, None]
    score = jnp.where(valid[None, :, None, :], imp + NSA_FORCE_BONUS * forced[None, :, None, :], NEG)
    n_top = min(NSA_SEL_TOP, n_sel)
    sel_score, sel_idx = lax.top_k(score, n_top)
    sel_ok = sel_score > 0.5 * NEG

    kb = jnp.moveaxis(k_s.reshape(B, n_sel, NSA_SEL_LEN, G, Dh), 3, 1)
    vb = jnp.moveaxis(v_s.reshape(B, n_sel, NSA_SEL_LEN, G, Dh), 3, 1)
    gather = jax.vmap(jax.vmap(lambda tbl, ix: tbl[ix]))

    def slc_block(start):
        qb = lax.dynamic_slice_in_dim(qg, start, Q_BLOCK, 1)
        ix = jnp.swapaxes(lax.dynamic_slice_in_dim(sel_idx, start, Q_BLOCK, 1), 1, 2)
        ok = jnp.swapaxes(lax.dynamic_slice_in_dim(sel_ok, start, Q_BLOCK, 1), 1, 2)
        kg = gather(kb, ix)
        vg = gather(vb, ix)
        s = jnp.einsum('bqgrd,bgqnld->bgrqnl', qb, kg, preferred_element_type=jnp.float32) * scale
        qpos = start + jnp.arange(Q_BLOCK)
        kpos = ix[..., None] * NSA_SEL_LEN + jnp.arange(NSA_SEL_LEN)
        mask = ((kpos <= qpos[:, None, None]) & ok[..., None])[:, :, None]
        s = jnp.where(mask, s, NEG).reshape(B, G, R, Q_BLOCK, -1)
        p = jax.nn.softmax(s, axis=-1)
        o = jnp.einsum('bgrqm,bgqmd->bqgrd', p.astype(vg.dtype), vg.reshape(B, G, Q_BLOCK, -1, Dh))
        return o.reshape(B, Q_BLOCK, H, Dh)

    o_slc = sweep_query_blocks(slc_block, S)

    pad = ((0, 0), (NSA_WINDOW, 0), (0, 0), (0, 0))
    kwp = jnp.pad(k_w, pad)
    vwp = jnp.pad(v_w, pad)

    def win_block(start):
        qb = lax.dynamic_slice_in_dim(qg, start, Q_BLOCK, 1)
        kband = lax.dynamic_slice_in_dim(kwp, start, Q_BLOCK + NSA_WINDOW, 1)
        vband = lax.dynamic_slice_in_dim(vwp, start, Q_BLOCK + NSA_WINDOW, 1)
        s = jnp.einsum('bqgrd,bkgd->bgrqk', qb, kband, preferred_element_type=jnp.float32) * scale
        qpos = start + jnp.arange(Q_BLOCK)
        kpos = start - NSA_WINDOW + jnp.arange(Q_BLOCK + NSA_WINDOW)
        d = qpos[:, None] - kpos[None, :]
        mask = (d >= 0) & (d < NSA_WINDOW) & (kpos[None, :] >= 0)
        p = jax.nn.softmax(jnp.where(mask, s, NEG), axis=-1)
        o = jnp.einsum('bgrqk,bkgd->bqgrd', p.astype(vband.dtype), vband)
        return o.reshape(B, Q_BLOCK, H, Dh)

    o_win = sweep_query_blocks(win_block, S)
    return gates[..., 0:1] * o_cmp + gates[..., 1:2] * o_slc + gates[..., 2:3] * o_win


def stick_breaking_attention(q, k, v):
    B, S, H, Dh = q.shape
    scale = Dh ** -0.5
    kpos = jnp.arange(S)

    def block(start):
        qb = lax.dynamic_slice_in_dim(q, start, Q_BLOCK, 1)
        z = jnp.einsum('bqhd,bkhd->bhqk', qb, k, preferred_element_type=jnp.float32) * scale
        qpos = start + jnp.arange(Q_BLOCK)
        mask = kpos[None, :] < qpos[:, None]
        log_beta = jax.nn.log_sigmoid(z)
        log_1m = jnp.where(mask, jax.nn.log_sigmoid(-z), 0.0)
        tail = lax.cumsum(log_1m, axis=3, reverse=True) - log_1m
        A = jnp.where(mask, jnp.exp(log_beta + tail), 0.0)
        return jnp.einsum('bhqk,bkhd->bqhd', A.astype(v.dtype), v)

    return sweep_query_blocks(block, S)


def peer_ffn(x, w_q, sub_k1, sub_k2, u_tab, v_tab):
    B, S, D = x.shape
    T = B * S
    xt = x.reshape(T, D)
    q = (xt @ w_q).reshape(T, PEER_HEADS, PEER_QDIM)
    half = PEER_QDIM // 2
    s1 = jnp.einsum('thd,hnd->thn', q[..., :half], sub_k1, preferred_element_type=jnp.float32)
    s2 = jnp.einsum('thd,hnd->thn', q[..., half:], sub_k2, preferred_element_type=jnp.float32)
    v1, i1 = lax.top_k(s1, PEER_TOPK)
    v2, i2 = lax.top_k(s2, PEER_TOPK)
    cand = (v1[..., :, None] + v2[..., None, :]).reshape(T, PEER_HEADS, PEER_TOPK * PEER_TOPK)
    cidx = (i1[..., :, None] * PEER_KEYS + i2[..., None, :]).reshape(T, PEER_HEADS, PEER_TOPK * PEER_TOPK)
    top_s, top_pos = lax.top_k(cand, PEER_TOPK)
    eidx = jnp.take_along_axis(cidx, top_pos, axis=-1)
    g = jax.nn.softmax(top_s, axis=-1)
    n_chunks = T // PEER_CHUNK
    xc = xt.reshape(n_chunks, PEER_CHUNK, D)
    ec = eidx.reshape(n_chunks, PEER_CHUNK, PEER_HEADS * PEER_TOPK)
    gc = g.reshape(n_chunks, PEER_CHUNK, PEER_HEADS * PEER_TOPK)

    def chunk(args):
        xb, eb, gb = args
        u = u_tab[eb]
        vv = v_tab[eb]
        a = jax.nn.gelu(jnp.einsum('cd,ced->ce', xb, u, preferred_element_type=jnp.float32),
                        approximate=False)
        return jnp.einsum('ce,ced->cd', (gb * a).astype(x.dtype), vv)

    return lax.map(chunk, (xc, ec, gc)).reshape(B, S, D)


def setup_inputs(seed: int = 0) -> dict:
    key = jax.random.key(seed)
    ks = jax.random.split(key, 24)
    L, D = DEPTH, D_MODEL
    f32 = jnp.float32

    def nrm(k, shape, fan_in):
        return jax.random.normal(k, shape, f32) * fan_in ** -0.5

    def gain(k, shape):
        return 1.0 + 0.02 * jax.random.normal(k, shape, f32)

    cmp_in = NSA_CMP_LEN * HEAD_DIM
    return {
        'x': jax.random.normal(ks[0], (BATCH, SEQ, D), f32),
        'attn_norm': gain(ks[1], (L, D)),
        'w_in': nrm(ks[2], (L, D, IN_WIDTH), D),
        'fox_forget_bias': 0.1 * jax.random.normal(ks[3], (L, MIX_HEADS), f32),
        'mla_q_norm': gain(ks[4], (L, MLA_Q_LORA)),
        'mla_kv_norm': gain(ks[5], (L, MLA_KV_LORA)),
        'mla_w_uq': nrm(ks[6], (L, MLA_Q_LORA, MIX_HEADS * (MLA_NOPE + MLA_ROPE)), MLA_Q_LORA),
        'mla_w_ukv': nrm(ks[7], (L, MLA_KV_LORA, MIX_HEADS * (MLA_NOPE + MLA_V)), MLA_KV_LORA),
        'nsa_cmp_k_pos': 0.02 * jax.random.normal(ks[8], (L, NSA_CMP_LEN, HEAD_DIM), f32),
        'nsa_cmp_k_w1': nrm(ks[9], (L, cmp_in, NSA_CMP_HIDDEN), cmp_in),
        'nsa_cmp_k_w2': nrm(ks[10], (L, NSA_CMP_HIDDEN, HEAD_DIM), NSA_CMP_HIDDEN),
        'nsa_cmp_v_pos': 0.02 * jax.random.normal(ks[11], (L, NSA_CMP_LEN, HEAD_DIM), f32),
        'nsa_cmp_v_w1': nrm(ks[12], (L, cmp_in, NSA_CMP_HIDDEN), cmp_in),
        'nsa_cmp_v_w2': nrm(ks[13], (L, NSA_CMP_HIDDEN, HEAD_DIM), NSA_CMP_HIDDEN),
        'w_branch': nrm(ks[14], (L, N_BRANCH, BRANCH_WIDTH, D), BRANCH_WIDTH),
        'w_out': nrm(ks[15], (L, D, D), D),
        'ffn_norm': gain(ks[16], (L, D)),
        'peer_w_q': nrm(ks[17], (L, D, PEER_HEADS * PEER_QDIM), D),
        'peer_sub_k1': nrm(ks[18], (L, PEER_HEADS, PEER_KEYS, PEER_QDIM // 2), PEER_QDIM // 2),
        'peer_sub_k2': nrm(ks[19], (L, PEER_HEADS, PEER_KEYS, PEER_QDIM // 2), PEER_QDIM // 2),
        'peer_u': nrm(ks[20], (L, PEER_EXPERTS, D), D),
        'peer_v': nrm(ks[21], (L, PEER_EXPERTS, D), PEER_HEADS),
        'final_norm': gain(ks[22], (D,)),
    }


def reference(x, attn_norm, w_in, fox_forget_bias, mla_q_norm, mla_kv_norm, mla_w_uq, mla_w_ukv,
              nsa_cmp_k_pos, nsa_cmp_k_w1, nsa_cmp_k_w2, nsa_cmp_v_pos, nsa_cmp_v_w1, nsa_cmp_v_w2,
              w_branch, w_out, ffn_norm, peer_w_q, peer_sub_k1, peer_sub_k2, peer_u, peer_v,
              final_norm):
    B, S, D = x.shape
    pos = jnp.arange(S)
    split_at = [int(c) for c in np.cumsum(IN_SPLITS)[:-1]]
    for l in range(DEPTH):
        h = rms_norm(x, attn_norm[l])
        (fq, fk, fv, ff, mcq, mckv, mkr, nq, nkc, nvc, nks, nvs, nkw, nvw, ng,
         sq, sk, sv, mg) = jnp.split(h @ w_in[l], split_at, axis=-1)

        log_f = jax.nn.log_sigmoid((ff + fox_forget_bias[l]).astype(jnp.float32))
        o_a = fox_attention(heads(fq, MIX_HEADS), heads(fk, MIX_HEADS), heads(fv, MIX_HEADS), log_f)
        o_b = mla_attention(mcq, mckv, mkr, mla_q_norm[l], mla_kv_norm[l], mla_w_uq[l], mla_w_ukv[l], pos)
        o_c = nsa_attention(heads(nq, MIX_HEADS), heads(nkc, NSA_KV_HEADS), heads(nvc, NSA_KV_HEADS),
                            heads(nks, NSA_KV_HEADS), heads(nvs, NSA_KV_HEADS),
                            heads(nkw, NSA_KV_HEADS), heads(nvw, NSA_KV_HEADS),
                            jax.nn.sigmoid(heads(ng, MIX_HEADS)), pos,
                            nsa_cmp_k_pos[l], nsa_cmp_k_w1[l], nsa_cmp_k_w2[l],
                            nsa_cmp_v_pos[l], nsa_cmp_v_w1[l], nsa_cmp_v_w2[l])
        o_d = stick_breaking_attention(heads(sq, MIX_HEADS), heads(sk, MIX_HEADS), heads(sv, MIX_HEADS))

        branches = jnp.stack([o.reshape(B, S, BRANCH_WIDTH) for o in (o_a, o_b, o_c, o_d)], axis=2)
        y = jnp.einsum('bsnc,ncd->bsnd', branches, w_branch[l])
        gate = jax.nn.sigmoid(mg.reshape(B, S, N_BRANCH, D))
        x = x + jnp.sum(gate * y, axis=2) @ w_out[l]

        x = x + peer_ffn(rms_norm(x, ffn_norm[l]), peer_w_q[l], peer_sub_k1[l], peer_sub_k2[l],
                         peer_u[l], peer_v[l])
    return rms_norm(x, final_norm)
```

```cpp
#include <hip/hip_runtime.h>
#include <cstdio>
#include <cstdint>


#define ONE_LAUNCH 1
#ifndef ABL
#define ABL 0
#endif
#define USE_PG8 1
#ifndef XDUP
#define XDUP 0
#endif
#ifndef UDBL
#define UDBL 0
#endif
#include <hip/hip_runtime.h>
#include <cstdio>
#include <cstdint>
namespace pg8 {
#define PG8_LAS __attribute__((address_space(3)))
typedef unsigned short bf16_t;
typedef short bf16x8 __attribute__((ext_vector_type(8)));
typedef float f32x4 __attribute__((ext_vector_type(4)));
typedef unsigned u32x4 __attribute__((ext_vector_type(4)));
typedef int i32x4 __attribute__((ext_vector_type(4)));
constexpr int BM = 256, BK = 64, HALF = 128, HTB = HALF * BK * 2  , STAGE_BYTES = 8 * HTB, NXCD = 8, WGM = 8;

__host__ __device__ __forceinline__ int lds_byte(int r, int c) { const int st = (r >> 4) * 2 + (c >> 5), rr = r & 15, cc = c & 31, ob = rr * 64 + cc * 2; return st * 1024 + (ob ^ (((ob >> 9) & 1) << 5)); }
__host__ __device__ __forceinline__ void stage_rc(int b, int& R, int& C) { const int st = b / 1024, sb = b % 1024, swz = sb ^ (((sb >> 9) & 1) << 5); R = (st >> 1) * 16 + swz / 64; C = (st & 1) * 32 + (swz % 64) / 2; }
__host__ __device__ __forceinline__ int perm32(int rho) { const int n = rho >> 4, i = rho & 15; return 8 * (i >> 2) + 4 * n + (i & 3); }

struct Unit { int pm, pn; };
struct Gemm { const bf16_t* A; const bf16_t* Bt; int M, N, K; };

struct StaticOrder {
    int nM, nN, nwg, G, c;
    __host__ __device__ __forceinline__ void init(int M, int N, int G_, int c_) { nM = M / BM; nN = N / BM; nwg = nM * nN; G = G_; c = c_; }
    __host__ __device__ __forceinline__ bool next(int i, Unit& u) const {
        const long L = (long)i * G + c; if (L >= nwg) return false;
        int wgid = (int)L; { const int q = nwg / NXCD, r = nwg % NXCD, xcd = wgid % NXCD, off = wgid / NXCD; wgid = (xcd < r ? xcd * (q + 1) : r * (q + 1) + (xcd - r) * q) + off; }
        const int nig = WGM * nN, gid = wgid / nig, fm = gid * WGM, gsz = (nM - fm) < WGM ? (nM - fm) : WGM;
        u.pm = fm + ((wgid % nig) % gsz); u.pn = (wgid % nig) / gsz; return true;
    }
    __device__ __forceinline__ void a_ready(const Unit&) const {}
    __device__ __forceinline__ void done(const Unit&) const {}
};

__device__ __forceinline__ unsigned cvt_pk_bf16(float lo, float hi) { typedef __bf16 bf2_t __attribute__((ext_vector_type(2))); typedef float f2_t __attribute__((ext_vector_type(2))); f2_t v = {lo, hi}; bf2_t b = __builtin_convertvector(v, bf2_t); return __builtin_bit_cast(unsigned, b); }
typedef float f32x2 __attribute__((ext_vector_type(2)));
typedef unsigned u32x2 __attribute__((ext_vector_type(2)));
__device__ __forceinline__ f32x2 gelu_pk(f32x2 v) {
    const f32x2 av = __builtin_elementwise_abs(v), d = av * 0.2316418882f + 1.0f;
    f32x2 t; t.x = __builtin_amdgcn_rcpf(d.x); t.y = __builtin_amdgcn_rcpf(d.y);
    f32x2 q = t * 0.5307027145f + (-0.7265760135f); q = q * t + 0.7107068705f; q = q * t + (-0.142248368f); q = q * t + 0.127414796f; q = q * t;
    const f32x2 s = (v * v) * (-0.72134752044f);
    f32x2 e; e.x = __builtin_amdgcn_exp2f(s.x); e.y = __builtin_amdgcn_exp2f(s.y);
    const f32x2 m = v * (q * e), r = v - m;
    f32x2 o; o.x = v.x < 0.f ? m.x : r.x; o.y = v.y < 0.f ? m.y : r.y; return o;
}
__device__ __forceinline__ float gelu1(float x) { f32x2 v = {x, 0.f}; return gelu_pk(v).x; }
__device__ __forceinline__ float sigmoidf_(float x) { return __builtin_amdgcn_rcpf(1.0f + __expf(-x)); }
__device__ __forceinline__ u32x4 pack8(f32x4 a, f32x4 b) { u32x4 w; w.x = cvt_pk_bf16(a[0], a[1]); w.y = cvt_pk_bf16(a[2], a[3]); w.z = cvt_pk_bf16(b[0], b[1]); w.w = cvt_pk_bf16(b[2], b[3]); return w; }
__device__ __forceinline__ u32x2 pack8u(f32x4 a, f32x4 b) { u32x2 w;
    w.x = (unsigned)__float2int_rn(a[0] * 255.f) | ((unsigned)__float2int_rn(a[1] * 255.f) << 8) | ((unsigned)__float2int_rn(a[2] * 255.f) << 16) | ((unsigned)__float2int_rn(a[3] * 255.f) << 24);
    w.y = (unsigned)__float2int_rn(b[0] * 255.f) | ((unsigned)__float2int_rn(b[1] * 255.f) << 8) | ((unsigned)__float2int_rn(b[2] * 255.f) << 16) | ((unsigned)__float2int_rn(b[3] * 255.f) << 24); return w; }
__device__ __forceinline__ unsigned short bf1(float x) { return (unsigned short)(cvt_pk_bf16(x, 0.f) & 0xffffu); }

constexpr int T_TOK = 8192, SEQ_ = 2048;
constexpr int ACT_LD = 5376, GATE_LD = 8192, MISC_LD = 64, VT_LD = 8192;

__device__ __forceinline__ void store_vt8(bf16_t* VT, int vtrow, int tok, f32x4 a, f32x4 b) {
    const unsigned o = ((unsigned)vtrow * (unsigned)VT_LD + (unsigned)tok) * 2u; unsigned char* base = (unsigned char*)VT;
#define VT_ST(k, v) *(bf16_t*)(base + (size_t)(o + (unsigned)(k) * (unsigned)VT_LD * 2u)) = bf1(v);
    VT_ST(0, a[0]) VT_ST(1, a[1]) VT_ST(2, a[2]) VT_ST(3, a[3]) VT_ST(4, b[0]) VT_ST(5, b[1]) VT_ST(6, b[2]) VT_ST(7, b[3])
#undef VT_ST
}

struct EpiWin {
    static constexpr bool PERM = true, AFTER_DRAIN = false;
    bf16_t* ACT; bf16_t* GATE; float* MISC; bf16_t* VT; const float* rope16; const float* sx; const float* sw;
    __device__ __forceinline__ f32x4 deq(const f32x4& v, float rs, const f32x4& w) const { const i32x4 q = __builtin_bit_cast(i32x4, v); return (f32x4){(float)q[0] * rs * w[0], (float)q[1] * rs * w[1], (float)q[2] * rs * w[2], (float)q[3] * rs * w[3]}; }
    __device__ __forceinline__ void operator()(const f32x4 (&acc)[2][2][4][2], const Unit& u, int wr, int wc, int fr, int fq) const {
        const int pn = u.pn; const int row0 = u.pm * BM + wr * 64 + fr; const int lc0 = wc * 32 + 8 * fq;
        const bool full_vt = (pn == 4 || pn == 5 || pn == 18 || pn == 19);
        const bool half_vt = (pn == 12 || pn == 13);
        const bool rope_t = (pn == 9 || pn == 10 || pn == 12 || pn == 13);
        const int vtbase = (pn == 4 || pn == 5) ? (pn - 4) * 256 : (pn == 18 || pn == 19) ? 512 + (pn - 18) * 256 : (pn == 12) ? 1024 - 128 : 1152 - 128;
        if (pn >= 20) {
        float rs[2][4]; f32x4 w0[2], w1[2];
#pragma unroll
        for (int ai = 0; ai < 2; ++ai)
#pragma unroll
            for (int m = 0; m < 4; ++m) rs[ai][m] = sx[row0 + ai * HALF + m * 16];
#pragma unroll
        for (int bj = 0; bj < 2; ++bj) { const float* swp = sw + pn * 256 + bj * HALF + lc0; w0[bj] = *(const f32x4*)swp; w1[bj] = *(const f32x4*)(swp + 4); }
        if (pn >= 21) {
#pragma unroll
            for (int ai = 0; ai < 2; ++ai)
#pragma unroll
                for (int m = 0; m < 4; ++m) { const int row = row0 + ai * HALF + m * 16;
#pragma unroll
                    for (int bj = 0; bj < 2; ++bj) { f32x4 a = deq(acc[ai][bj][m][0], rs[ai][m], w0[bj]), b = deq(acc[ai][bj][m][1], rs[ai][m], w1[bj]);
#pragma unroll
                        for (int i = 0; i < 4; ++i) { a[i] = sigmoidf_(a[i]); b[i] = sigmoidf_(b[i]); }
                        *(u32x2*)((unsigned char*)GATE + (size_t)((unsigned)row * (unsigned)GATE_LD + (unsigned)((pn - 21) * 256 + bj * HALF + lc0))) = pack8u(a, b); } }
            return;
        }
        if (pn == 20) {
            if (wc < 2) {
#pragma unroll
                for (int ai = 0; ai < 2; ++ai)
#pragma unroll
                    for (int m = 0; m < 4; ++m) { const int row = row0 + ai * HALF + m * 16; float* p = MISC + (size_t)row * MISC_LD + lc0;
                        *(f32x4*)p = deq(acc[ai][0][m][0], rs[ai][m], w0[0]); *(f32x4*)(p + 4) = deq(acc[ai][0][m][1], rs[ai][m], w1[0]); }
            }
            return;
        }
        }
        if (rope_t) {
            const bool do_rope = ((wc & 1) == 0) && fq < 2;
#pragma unroll
            for (int ai = 0; ai < 2; ++ai)
#pragma unroll
                for (int m = 0; m < 4; ++m) { const int row = row0 + ai * HALF + m * 16; const float rsr = sx[row];
#pragma unroll
                    for (int bj = 0; bj < 2; ++bj) { const int lc = bj * HALF + lc0; const float* swp = sw + pn * 256 + lc; f32x4 a = deq(acc[ai][bj][m][0], rsr, *(const f32x4*)swp), b = deq(acc[ai][bj][m][1], rsr, *(const f32x4*)(swp + 4));
                        if (half_vt && bj == 1) { store_vt8(VT, vtbase + lc, row, a, b); continue; }
                        if (do_rope) {
                            const f32x4* rp = (const f32x4*)(rope16 + ((size_t)(row & (SEQ_ - 1)) * 8 + 4 * fq) * 2);
                            const f32x4 c0 = rp[0], c1 = rp[1];
                            f32x4 a2, b2;
                            a2[0] = a[0] * c0[0] - a[1] * c0[1]; a2[1] = a[0] * c0[1] + a[1] * c0[0];
                            a2[2] = a[2] * c0[2] - a[3] * c0[3]; a2[3] = a[2] * c0[3] + a[3] * c0[2];
                            b2[0] = b[0] * c1[0] - b[1] * c1[1]; b2[1] = b[0] * c1[1] + b[1] * c1[0];
                            b2[2] = b[2] * c1[2] - b[3] * c1[3]; b2[3] = b[2] * c1[3] + b[3] * c1[2];
                            a = a2; b = b2;
                        }
                        *(u32x4*)((unsigned char*)ACT + (size_t)(((unsigned)row * (unsigned)ACT_LD + (unsigned)(pn * 256 + lc)) * 2u)) = pack8(a, b); } }
            return;
        }
        float rs[2][4]; f32x4 w0[2], w1[2];
#pragma unroll
        for (int ai = 0; ai < 2; ++ai)
#pragma unroll
            for (int m = 0; m < 4; ++m) rs[ai][m] = sx[row0 + ai * HALF + m * 16];
#pragma unroll
        for (int bj = 0; bj < 2; ++bj) { const float* swp = sw + pn * 256 + bj * HALF + lc0; w0[bj] = *(const f32x4*)swp; w1[bj] = *(const f32x4*)(swp + 4); }
#pragma unroll
        for (int ai = 0; ai < 2; ++ai)
#pragma unroll
            for (int m = 0; m < 4; ++m) { const int row = row0 + ai * HALF + m * 16;
#pragma unroll
                for (int bj = 0; bj < 2; ++bj) { const int lc = bj * HALF + lc0; f32x4 a = deq(acc[ai][bj][m][0], rs[ai][m], w0[bj]), b = deq(acc[ai][bj][m][1], rs[ai][m], w1[bj]);
                    if (full_vt) { store_vt8(VT, vtbase + lc, row, a, b); continue; }
                    *(u32x4*)((unsigned char*)ACT + (size_t)(((unsigned)row * (unsigned)ACT_LD + (unsigned)(pn * 256 + lc)) * 2u)) = pack8(a, b); } }
    }
};

struct EpiGate8 {
    static constexpr bool PERM = true, AFTER_DRAIN = false;
    bf16_t* GATE; const float* sx; const float* sw;
    __device__ __forceinline__ void operator()(const f32x4 (&acc)[2][2][4][2], const Unit& u, int wr, int wc, int fr, int fq) const {
        const int row0 = u.pm * BM + wr * 64 + fr; const int c00 = u.pn * BM + wc * 32 + 8 * fq;
        f32x4 w0[2], w1[2];
#pragma unroll
        for (int bj = 0; bj < 2; ++bj) { w0[bj] = *(const f32x4*)(sw + c00 + bj * HALF); w1[bj] = *(const f32x4*)(sw + c00 + bj * HALF + 4); }
#pragma unroll
        for (int ai = 0; ai < 2; ++ai)
#pragma unroll
            for (int m = 0; m < 4; ++m) { const int row = row0 + ai * HALF + m * 16; const float rs = sx[row];
#pragma unroll
                for (int bj = 0; bj < 2; ++bj) { const i32x4 ia = __builtin_bit_cast(i32x4, acc[ai][bj][m][0]), ib = __builtin_bit_cast(i32x4, acc[ai][bj][m][1]); f32x4 a, b;
#pragma unroll
                    for (int i = 0; i < 4; ++i) { a[i] = sigmoidf_((float)ia[i] * rs * w0[bj][i]); b[i] = sigmoidf_((float)ib[i] * rs * w1[bj][i]); }
                    *(u32x4*)(GATE + (size_t)row * GATE_LD + c00 + bj * HALF) = pack8(a, b); } }
    }
};

struct EpiQ8 {
    static constexpr bool PERM = true, AFTER_DRAIN = false;
    bf16_t* O; int ld; const float* sx; const float* sw;
    __device__ __forceinline__ void operator()(const f32x4 (&acc)[2][2][4][2], const Unit& u, int wr, int wc, int fr, int fq) const {
        const int row0 = u.pm * BM + wr * 64 + fr; const int c00 = u.pn * BM + wc * 32 + 8 * fq;
        f32x4 w0[2], w1[2];
#pragma unroll
        for (int bj = 0; bj < 2; ++bj) { w0[bj] = *(const f32x4*)(sw + c00 + bj * HALF); w1[bj] = *(const f32x4*)(sw + c00 + bj * HALF + 4); }
        float rsv[2][4];
#pragma unroll
        for (int ai = 0; ai < 2; ++ai)
#pragma unroll
            for (int m = 0; m < 4; ++m) rsv[ai][m] = sx[row0 + ai * HALF + m * 16];
#pragma unroll
        for (int ai = 0; ai < 2; ++ai)
#pragma unroll
            for (int m = 0; m < 4; ++m) { const int row = row0 + ai * HALF + m * 16; const float rs = rsv[ai][m];
#pragma unroll
                for (int bj = 0; bj < 2; ++bj) { const i32x4 ia = __builtin_bit_cast(i32x4, acc[ai][bj][m][0]), ib = __builtin_bit_cast(i32x4, acc[ai][bj][m][1]); f32x4 a, b;
#pragma unroll
                    for (int i = 0; i < 4; ++i) { a[i] = (float)ia[i] * rs * w0[bj][i]; b[i] = (float)ib[i] * rs * w1[bj][i]; }
                    *(u32x4*)(O + (size_t)row * ld + c00 + bj * HALF) = pack8(a, b); } }
    }
};

struct EpiGen {
    static constexpr bool PERM = true, AFTER_DRAIN = false;
    bf16_t* O; int ld, hs, act, vt_split, vt_row0, ncols, nrows; bf16_t* VT;
    __device__ __forceinline__ void operator()(const f32x4 (&acc)[2][2][4][2], const Unit& u, int wr, int wc, int fr, int fq) const {
        const int row0 = u.pm * BM + wr * 64 + fr; const int c00 = u.pn * BM + wc * 32 + 8 * fq;
#pragma unroll
        for (int ai = 0; ai < 2; ++ai)
#pragma unroll
            for (int m = 0; m < 4; ++m) { const int row = row0 + ai * HALF + m * 16; if (row >= nrows) continue;
#pragma unroll
                for (int bj = 0; bj < 2; ++bj) { f32x4 a = acc[ai][bj][m][0], b = acc[ai][bj][m][1]; const int c = c00 + bj * HALF; if (c >= ncols) continue;
                    if (c >= vt_split) { store_vt8(VT, vt_row0 + c - vt_split, row, a, b); continue; }
                    if (act == 1) { f32x2 x0 = gelu_pk((f32x2){a[0], a[1]}), x1 = gelu_pk((f32x2){a[2], a[3]}), x2 = gelu_pk((f32x2){b[0], b[1]}), x3 = gelu_pk((f32x2){b[2], b[3]});
                        a = (f32x4){x0.x, x0.y, x1.x, x1.y}; b = (f32x4){x2.x, x2.y, x3.x, x3.y}; }
                    *(u32x4*)(O + (size_t)row * ld + (c >> 6) * hs + (c & 63)) = pack8(a, b); } }
    }
};

struct EpiCmp2 {
    static constexpr bool PERM = true, AFTER_DRAIN = false;
    bf16_t* OUT; int is_k; const float* rope16;
    __device__ __forceinline__ void operator()(const f32x4 (&acc)[2][2][4][2], const Unit& u, int wr, int wc, int fr, int fq) const {
        if (wc >= 2) return;
        const int row0 = u.pm * BM + wr * 64 + fr; const int c0 = wc * 32 + 8 * fq;
#pragma unroll
        for (int ai = 0; ai < 2; ++ai)
#pragma unroll
            for (int m = 0; m < 4; ++m) { const int R = row0 + ai * HALF + m * 16; if (R >= 1016) continue;
                const int g = R & 1, bc = R >> 1, b = bc / 127, c = bc - b * 127;
                f32x4 a = acc[ai][0][m][0], bq = acc[ai][0][m][1];
                if (is_k) {
                    if (c0 < 16) { const int pos = 16 * c + 31;
                        const f32x4* rp = (const f32x4*)(rope16 + ((size_t)pos * 8 + 4 * fq) * 2); const f32x4 c0v = rp[0], c1v = rp[1]; f32x4 a2, b2;
                        a2[0] = a[0] * c0v[0] - a[1] * c0v[1]; a2[1] = a[0] * c0v[1] + a[1] * c0v[0];
                        a2[2] = a[2] * c0v[2] - a[3] * c0v[3]; a2[3] = a[2] * c0v[3] + a[3] * c0v[2];
                        b2[0] = bq[0] * c1v[0] - bq[1] * c1v[1]; b2[1] = bq[0] * c1v[1] + bq[1] * c1v[0];
                        b2[2] = bq[2] * c1v[2] - bq[3] * c1v[3]; b2[3] = bq[2] * c1v[3] + bq[3] * c1v[2];
                        a = a2; bq = b2; }
                    *(u32x4*)(OUT + ((size_t)((b * 2 + g) * 128 + c)) * 64 + c0) = pack8(a, bq);
                } else {
                    bf16_t* p = OUT + ((size_t)((b * 2 + g) * 64 + c0)) * 128 + c;
                    p[0 * 128] = bf1(a[0]); p[1 * 128] = bf1(a[1]); p[2 * 128] = bf1(a[2]); p[3 * 128] = bf1(a[3]);
                    p[4 * 128] = bf1(bq[0]); p[5 * 128] = bf1(bq[1]); p[6 * 128] = bf1(bq[2]); p[7 * 128] = bf1(bq[3]);
                } }
    }
};

struct EpiBranch {
    static constexpr bool PERM = true, AFTER_DRAIN = false;
    const bf16_t* GATE; bf16_t* ZF; bf16_t* Z;
    __device__ __forceinline__ void operator()(const f32x4 (&acc)[2][2][4][2], const Unit& u, int wr, int wc, int fr, int fq) const {
        const int n = u.pm >> 5, pm = u.pm & 31, pn = u.pn & 7;
        const int row0 = pm * BM + wr * 64 + fr; const int c00 = pn * BM + wc * 32 + 8 * fq;
        u32x2 gw[2][4][2]; u32x4 zw[4][2], res[4][2];
#define EB_RO(ai, m) ((unsigned)(row0 + (ai) * HALF + (m) * 16))
#define EB_C(bj) ((unsigned)(c00 + (bj) * HALF))
#pragma unroll
        for (int ai = 0; ai < 2; ++ai)
#pragma unroll
            for (int m = 0; m < 4; ++m)
#pragma unroll
                for (int bj = 0; bj < 2; ++bj) gw[ai][m][bj] = *(const u32x2*)((const unsigned char*)GATE + (size_t)(EB_RO(ai, m) * (unsigned)GATE_LD + (unsigned)n * 2048u + EB_C(bj)));
#pragma unroll
        for (int ai = 0; ai < 2; ++ai) {
            if (n > 0 && ai == 0) {
#pragma unroll
                for (int m = 0; m < 4; ++m)
#pragma unroll
                    for (int bj = 0; bj < 2; ++bj) zw[m][bj] = *(const u32x4*)((const unsigned char*)ZF + (size_t)((EB_RO(0, m) * 2048u + EB_C(bj)) * 2u)); }
#pragma unroll
            for (int m = 0; m < 4; ++m)
#pragma unroll
                for (int bj = 0; bj < 2; ++bj) { const u32x2 g = gw[ai][m][bj];
                    f32x4 g0, g1; constexpr float I255 = 1.0f / 255.0f;
                    g0[0] = (float)(g.x & 255u) * I255; g0[1] = (float)((g.x >> 8) & 255u) * I255; g0[2] = (float)((g.x >> 16) & 255u) * I255; g0[3] = (float)(g.x >> 24) * I255;
                    g1[0] = (float)(g.y & 255u) * I255; g1[1] = (float)((g.y >> 8) & 255u) * I255; g1[2] = (float)((g.y >> 16) & 255u) * I255; g1[3] = (float)(g.y >> 24) * I255;
                    f32x4 a = acc[ai][bj][m][0] * g0, b = acc[ai][bj][m][1] * g1;
                    if (n > 0) { const u32x4 z = zw[m][bj];
                        a[0] += __uint_as_float(z.x << 16); a[1] += __uint_as_float(z.x & 0xffff0000u); a[2] += __uint_as_float(z.y << 16); a[3] += __uint_as_float(z.y & 0xffff0000u);
                        b[0] += __uint_as_float(z.z << 16); b[1] += __uint_as_float(z.z & 0xffff0000u); b[2] += __uint_as_float(z.w << 16); b[3] += __uint_as_float(z.w & 0xffff0000u); }
                    res[m][bj] = pack8(a, b); }
            if (n > 0 && ai == 0) {
#pragma unroll
                for (int m = 0; m < 4; ++m)
#pragma unroll
                    for (int bj = 0; bj < 2; ++bj) zw[m][bj] = *(const u32x4*)((const unsigned char*)ZF + (size_t)((EB_RO(1, m) * 2048u + EB_C(bj)) * 2u)); }
#pragma unroll
            for (int m = 0; m < 4; ++m)
#pragma unroll
                for (int bj = 0; bj < 2; ++bj) *(u32x4*)((unsigned char*)(n < 3 ? ZF : Z) + (size_t)((EB_RO(ai, m) * 2048u + EB_C(bj)) * 2u)) = res[m][bj];
        }
#undef EB_RO
#undef EB_C
    }
};
struct BranchOrder {
    int G, c;
    __device__ __forceinline__ bool next(int i, Unit& u) const { const int tile = (i >> 2) * G + c; if (tile >= 256) return false; const int n = i & 3; u.pm = n * 32 + (tile >> 3); u.pn = n * 8 + (tile & 7); return true; }
    __device__ __forceinline__ void a_ready(const Unit&) const {}
    __device__ __forceinline__ void done(const Unit&) const {}
};

struct EpiPart {
    static constexpr bool PERM = false, AFTER_DRAIN = false;
    float* PART;
    __device__ __forceinline__ void operator()(const f32x4 (&acc)[2][2][4][2], const Unit& u, int wr, int wc, int fr, int fq) const {
        const int s = u.pn, pm = u.pm & 3; const int row0 = pm * BM + wr * 64 + fr; const int c00 = wc * 32 + 4 * fq; float* base = PART + (size_t)s * 1024 * 256;
#pragma unroll
        for (int ai = 0; ai < 2; ++ai)
#pragma unroll
            for (int m = 0; m < 4; ++m) { float* rp = base + (size_t)(row0 + ai * HALF + m * 16) * 256;
#pragma unroll
                for (int bj = 0; bj < 2; ++bj)
#pragma unroll
                    for (int n = 0; n < 2; ++n) *(f32x4*)(rp + c00 + bj * HALF + n * 16) = acc[ai][bj][m][n]; }
    }
};
struct SliceOrder {
    int c;
    __device__ __forceinline__ bool next(int i, Unit& u) const { if (i > 0) return false; u.pm = c; u.pn = c >> 2; return true; }
    __device__ __forceinline__ void a_ready(const Unit&) const {}
    __device__ __forceinline__ void done(const Unit&) const {}
};

struct EpiResid {
    static constexpr bool PERM = true, AFTER_DRAIN = false;
    const float* XIf; const bf16_t* XIh; bf16_t* XO;
    __device__ __forceinline__ void operator()(const f32x4 (&acc)[2][2][4][2], const Unit& u, int wr, int wc, int fr, int fq) const {
        const int row0 = u.pm * BM + wr * 64 + fr; const int c00 = u.pn * BM + wc * 32 + 8 * fq;
#define ER_O(ai, m, bj) (((unsigned)(row0 + (ai) * HALF + (m) * 16) * 2048u + (unsigned)(c00 + (bj) * HALF)))
        if (XIh) {
            u32x4 w[16];
#define ER_LD(k) w[k] = *(const u32x4*)((const unsigned char*)XIh + (size_t)(ER_O((k) >> 3, ((k) >> 1) & 3, (k) & 1) * 2u));
#define ER_ST(k) { const u32x4 x = w[k]; const f32x4 xa = {__uint_as_float(x.x << 16), __uint_as_float(x.x & 0xffff0000u), __uint_as_float(x.y << 16), __uint_as_float(x.y & 0xffff0000u)}; \
                   const f32x4 xb = {__uint_as_float(x.z << 16), __uint_as_float(x.z & 0xffff0000u), __uint_as_float(x.w << 16), __uint_as_float(x.w & 0xffff0000u)}; \
                   *(u32x4*)((unsigned char*)XO + (size_t)(ER_O((k) >> 3, ((k) >> 1) & 3, (k) & 1) * 2u)) = pack8(xa + acc[(k) >> 3][(k) & 1][((k) >> 1) & 3][0], xb + acc[(k) >> 3][(k) & 1][((k) >> 1) & 3][1]); }
            ER_LD(0) ER_LD(1) ER_LD(2) ER_LD(3) ER_LD(4) ER_LD(5) ER_LD(6) ER_LD(7) ER_LD(8) ER_LD(9) ER_LD(10) ER_LD(11)
            ER_ST(0) ER_ST(1) ER_ST(2) ER_ST(3)
            ER_LD(12) ER_LD(13) ER_LD(14) ER_LD(15)
            ER_ST(4) ER_ST(5) ER_ST(6) ER_ST(7) ER_ST(8) ER_ST(9) ER_ST(10) ER_ST(11) ER_ST(12) ER_ST(13) ER_ST(14) ER_ST(15)
#undef ER_LD
#undef ER_ST
            return;
        }
#pragma unroll
        for (int ai = 0; ai < 2; ++ai)
#pragma unroll
            for (int mh = 0; mh < 4; mh += 2) { f32x4 xa[2][2], xb[2][2];
#pragma unroll
                for (int m = 0; m < 2; ++m)
#pragma unroll
                    for (int bj = 0; bj < 2; ++bj) { const float* px = (const float*)((const unsigned char*)XIf + (size_t)(ER_O(ai, mh + m, bj) * 4u)); xa[m][bj] = *(const f32x4*)px; xb[m][bj] = *(const f32x4*)(px + 4); }
#pragma unroll
                for (int m = 0; m < 2; ++m)
#pragma unroll
                    for (int bj = 0; bj < 2; ++bj) *(u32x4*)((unsigned char*)XO + (size_t)(ER_O(ai, mh + m, bj) * 2u)) = pack8(xa[m][bj] + acc[ai][bj][mh + m][0], xb[m][bj] + acc[ai][bj][mh + m][1]); }
#undef ER_O
    }
};
template <class Epi, class Sched, bool ALIGN_EPI = false, bool SP2 = false, bool I8 = false>
__device__ __forceinline__ void gemm_phase(PG8_LAS unsigned char* lds, const Gemm g, const Sched& S, const Epi& E) {
    int tid_ = threadIdx.x; asm volatile("" : "+v"(tid_));
    const int tid = tid_, wid = __builtin_amdgcn_readfirstlane(tid >> 6), lane = tid & 63, wr = wid >> 2, wc = wid & 3, fr = lane & 15, fq = lane >> 4;
    const int K = g.K, nt = K / BK;
    unsigned voffA[2], voffB[2];
#pragma unroll
    for (int i = 0; i < 2; ++i) { int R, C; stage_rc(tid * 16 + i * 8192, R, C); const int Rb = Epi::PERM ? ((R & ~31) + perm32(R & 31)) : R;
        voffA[i] = (unsigned)(R * K + C) * 2u; voffB[i] = (unsigned)(Rb * K + C) * 2u; }
    const size_t kstep = (size_t)(BK * 2);
    const size_t hstep = (size_t)HALF * K * 2;
    const size_t tstep = 2 * hstep;
    const unsigned ldsw = (unsigned)wid * 1024u;
    const int aoff = lds_byte(wr * 64 + fr, fq * 8), boff = lds_byte(wc * 32 + fr, fq * 8);
#define PG8_SA(b, h) (((b) * 2 + (h)) * HTB)
#define PG8_SB(b, h) ((4 + (b) * 2 + (h)) * HTB)
#define PG8_STAGE(bufoff, gbase, voff) do { _Pragma("unroll") for (int _i = 0; _i < 2; ++_i) \
        __builtin_amdgcn_global_load_lds((const unsigned*)((const char*)(gbase) + (voff)[_i]), (PG8_LAS unsigned*)(lds + (bufoff) + ldsw + _i * 8192), 16, 0, 0); } while (0)
#define PG8_LDA(dst, b, h) do { _Pragma("unroll") for (int m = 0; m < 4; ++m) _Pragma("unroll") for (int k = 0; k < 2; ++k) dst[m][k] = *(const PG8_LAS bf16x8*)(lds + PG8_SA(b, h) + aoff + m * 2048 + k * 1024); } while (0)
#define PG8_LDB(dst, b, h) do { _Pragma("unroll") for (int n = 0; n < 2; ++n) _Pragma("unroll") for (int k = 0; k < 2; ++k) dst[n][k] = *(const PG8_LAS bf16x8*)(lds + PG8_SB(b, h) + boff + n * 2048 + k * 1024); } while (0)
#define PG8_MMA(ai, bj, At, Bt) do { __builtin_amdgcn_s_setprio(1); _Pragma("unroll") for (int m = 0; m < 4; ++m) _Pragma("unroll") for (int n = 0; n < 2; ++n) _Pragma("unroll") for (int k = 0; k < 2; ++k) \
        { if constexpr (I8) acc[ai][bj][m][n] = __builtin_bit_cast(f32x4, __builtin_amdgcn_mfma_i32_16x16x64_i8(__builtin_bit_cast(i32x4, Bt[n][k]), __builtin_bit_cast(i32x4, At[m][k]), __builtin_bit_cast(i32x4, acc[ai][bj][m][n]), 0, 0, 0)); \
          else acc[ai][bj][m][n] = __builtin_amdgcn_mfma_f32_16x16x32_bf16(Bt[n][k], At[m][k], acc[ai][bj][m][n], 0, 0, 0); } __builtin_amdgcn_s_setprio(0); } while (0)
#ifdef PG8_DRAIN_ALL
#define PG8_WAIT_V(n) asm volatile("s_waitcnt vmcnt(0)" ::: "memory")
#else
#define PG8_WAIT_V(n) asm volatile("s_waitcnt vmcnt(" #n ")" ::: "memory")
#endif
#define PG8_WAIT_L(n) asm volatile("s_waitcnt lgkmcnt(" #n ")" ::: "memory")
#define PG8_BAR __builtin_amdgcn_s_barrier()
#define PG8_SCHED __builtin_amdgcn_sched_barrier(0)
    Unit cur, nxt; int ui = 0;
    if (!S.next(0, cur)) return;
    f32x4 acc[2][2][4][2];
#pragma unroll
    for (int a = 0; a < 2; ++a)
#pragma unroll
        for (int b = 0; b < 2; ++b)
#pragma unroll
            for (int m = 0; m < 4; ++m)
#pragma unroll
                for (int n = 0; n < 2; ++n) acc[a][b][m][n] = (f32x4){0.f, 0.f, 0.f, 0.f};
    bf16x8 At[4][2], B0[2][2], B1[2][2];
    const char* cA = (const char*)g.A + (size_t)cur.pm * tstep; const char* cB = (const char*)g.Bt + (size_t)cur.pn * tstep;
    S.a_ready(cur);
    if constexpr (SP2) {
        PG8_STAGE(PG8_SB(0, 0), cB, voffB); PG8_STAGE(PG8_SB(0, 1), cB + hstep, voffB); PG8_STAGE(PG8_SA(0, 0), cA, voffA); PG8_STAGE(PG8_SA(0, 1), cA + hstep, voffA);
        if (wr == 1) PG8_BAR;
        PG8_WAIT_V(2); PG8_BAR;
        PG8_STAGE(PG8_SB(1, 0), cB + kstep, voffB); PG8_STAGE(PG8_SA(1, 0), cA + kstep, voffA); PG8_STAGE(PG8_SB(1, 1), cB + hstep + kstep, voffB);
        PG8_WAIT_V(6); PG8_BAR;
    } else {
        PG8_STAGE(PG8_SB(0, 0), cB, voffB); PG8_STAGE(PG8_SA(0, 0), cA, voffA); PG8_STAGE(PG8_SB(0, 1), cB + hstep, voffB); PG8_STAGE(PG8_SA(0, 1), cA + hstep, voffA);
        if (wr == 1) PG8_BAR;
        PG8_WAIT_V(4); PG8_BAR;
        PG8_STAGE(PG8_SB(1, 0), cB + kstep, voffB); PG8_STAGE(PG8_SA(1, 0), cA + kstep, voffA); PG8_STAGE(PG8_SB(1, 1), cB + hstep + kstep, voffB);
        PG8_WAIT_V(6); PG8_BAR;
    }
    for (;;) {
        const bool has_next = S.next(ui + 1, nxt);
        const char* nA = has_next ? (const char*)g.A + (size_t)nxt.pm * tstep : cA; const char* nB = has_next ? (const char*)g.Bt + (size_t)nxt.pn * tstep : cB;
        for (int t = 0; t < nt; t += 2) {
            const bool last = (t == nt - 2);
            const char* a1 = cA + (size_t)(t + 1) * kstep;
            const char* a2 = last ? nA : cA + (size_t)(t + 2) * kstep; const char* b2 = last ? nB : cB + (size_t)(t + 2) * kstep;
            const char* a3 = a2 + kstep; const char* b3 = b2 + kstep;
            if (last && has_next) S.a_ready(nxt);
            if constexpr (SP2) {
            PG8_LDB(B0, 0, 0); PG8_LDB(B1, 0, 1); PG8_SCHED; PG8_LDA(At, 0, 0); PG8_STAGE(PG8_SA(1, 1), a1 + hstep, voffA);
            PG8_WAIT_V(8); PG8_WAIT_L(0); PG8_BAR; PG8_MMA(0, 0, At, B0); PG8_MMA(0, 1, At, B1); PG8_BAR; PG8_SCHED;
            PG8_LDA(At, 0, 1); PG8_STAGE(PG8_SB(0, 0), b2, voffB); PG8_STAGE(PG8_SB(0, 1), b2 + hstep, voffB); PG8_STAGE(PG8_SA(0, 0), a2, voffA);
            PG8_WAIT_V(8); PG8_WAIT_L(0); PG8_BAR; PG8_MMA(1, 0, At, B0); PG8_MMA(1, 1, At, B1); PG8_BAR; PG8_SCHED;
            PG8_LDB(B0, 1, 0); PG8_LDB(B1, 1, 1); PG8_SCHED; PG8_LDA(At, 1, 0); PG8_STAGE(PG8_SA(0, 1), a2 + hstep, voffA);
            PG8_WAIT_V(8); PG8_WAIT_L(0); PG8_BAR; PG8_MMA(0, 0, At, B0); PG8_MMA(0, 1, At, B1); PG8_BAR; PG8_SCHED;
            PG8_LDA(At, 1, 1); PG8_STAGE(PG8_SB(1, 0), b3, voffB); PG8_STAGE(PG8_SB(1, 1), b3 + hstep, voffB); PG8_STAGE(PG8_SA(1, 0), a3, voffA);
            PG8_WAIT_V(8); PG8_WAIT_L(0); PG8_BAR; PG8_MMA(1, 0, At, B0); PG8_MMA(1, 1, At, B1); PG8_BAR; PG8_SCHED;
            } else {
            PG8_LDB(B0, 0, 0); PG8_SCHED; PG8_LDA(At, 0, 0); PG8_STAGE(PG8_SA(1, 1), a1 + hstep, voffA);
            PG8_WAIT_L(8); PG8_BAR; PG8_WAIT_L(0); PG8_MMA(0, 0, At, B0); PG8_BAR; PG8_SCHED;
            PG8_LDB(B1, 0, 1); PG8_STAGE(PG8_SB(0, 0), b2, voffB);
            PG8_BAR; PG8_WAIT_L(0); PG8_MMA(0, 1, At, B1); PG8_BAR;
            PG8_LDA(At, 0, 1); PG8_STAGE(PG8_SA(0, 0), a2, voffA);
            PG8_BAR; PG8_WAIT_L(0); PG8_MMA(1, 0, At, B0); PG8_BAR; PG8_SCHED;
            PG8_STAGE(PG8_SB(0, 1), b2 + hstep, voffB);
            PG8_WAIT_V(6); PG8_BAR; PG8_MMA(1, 1, At, B1); PG8_BAR;
            PG8_LDB(B0, 1, 0); PG8_SCHED; PG8_LDA(At, 1, 0); PG8_STAGE(PG8_SA(0, 1), a2 + hstep, voffA);
            PG8_WAIT_L(8); PG8_BAR; PG8_WAIT_L(0); PG8_MMA(0, 0, At, B0); PG8_BAR; PG8_SCHED;
            PG8_LDB(B1, 1, 1); PG8_STAGE(PG8_SB(1, 0), b3, voffB);
            PG8_BAR; PG8_WAIT_L(0); PG8_MMA(0, 1, At, B1); PG8_BAR;
            PG8_LDA(At, 1, 1); PG8_STAGE(PG8_SA(1, 0), a3, voffA);
            PG8_BAR; PG8_WAIT_L(0); PG8_MMA(1, 0, At, B0); PG8_BAR; PG8_SCHED;
            PG8_STAGE(PG8_SB(1, 1), b3 + hstep, voffB);
            PG8_WAIT_V(6); PG8_BAR; PG8_MMA(1, 1, At, B1); PG8_BAR;
            }
        }
        if constexpr (ALIGN_EPI) { if (wr == 0) PG8_BAR; }
        if constexpr (!Epi::AFTER_DRAIN) { E(acc, cur, wr, wc, fr, fq); asm volatile("s_waitcnt vmcnt(0)" ::: "memory"); S.done(cur); }
        if (!has_next) break;
#pragma unroll
        for (int a = 0; a < 2; ++a)
#pragma unroll
            for (int b = 0; b < 2; ++b)
#pragma unroll
                for (int m = 0; m < 4; ++m)
#pragma unroll
                    for (int n = 0; n < 2; ++n) acc[a][b][m][n] = (f32x4){0.f, 0.f, 0.f, 0.f};
        cur = nxt; cA = nA; cB = nB; ++ui;
        if constexpr (ALIGN_EPI) { if (wr == 1) PG8_BAR; }
    }
    PG8_WAIT_V(0);
    if constexpr (!ALIGN_EPI) { if (wr == 0) PG8_BAR; }
    PG8_BAR;
    if constexpr (Epi::AFTER_DRAIN) { E.fused(acc, cur, wr, wc, fr, fq, lds, wid, lane); S.done(cur); }
#undef PG8_SA
#undef PG8_SB
#undef PG8_STAGE
#undef PG8_LDA
#undef PG8_LDB
#undef PG8_MMA
#undef PG8_WAIT_V
#undef PG8_WAIT_L
#undef PG8_BAR
#undef PG8_SCHED
}
}
namespace pg8 {
template <class Epi, class Sched>
__device__ __forceinline__ void gemm_simple(PG8_LAS unsigned char* lds, const Gemm g, const Sched& S, const Epi& E) {
    int tid_ = threadIdx.x; asm volatile("" : "+v"(tid_));
    const int tid = tid_, wid = __builtin_amdgcn_readfirstlane(tid >> 6), lane = tid & 63, wr = wid >> 2, wc = wid & 3, fr = lane & 15, fq = lane >> 4;
    const int K = g.K, nt = K / BK; constexpr int LSTR = 144;
    PG8_LAS unsigned char* As = lds; PG8_LAS unsigned char* Bs = lds + 256 * LSTR;
    const int srow = tid >> 3, sch = tid & 7;
    const int aoff = (wr * 64 + fr) * LSTR + fq * 16;
    int boff[2];
#pragma unroll
    for (int n = 0; n < 2; ++n) boff[n] = (wc * 32 + (Epi::PERM ? perm32(16 * n + fr) : 16 * n + fr)) * LSTR + fq * 16;
    Unit cur;
    for (int ui = 0; S.next(ui, cur); ++ui) {
        const bf16_t* Ag = g.A + (size_t)cur.pm * BM * K + (size_t)srow * K + sch * 8; const bf16_t* Bg = g.Bt + (size_t)cur.pn * BM * K + (size_t)srow * K + sch * 8;
        f32x4 acc[2][2][4][2];
#pragma unroll
        for (int a = 0; a < 2; ++a)
#pragma unroll
            for (int b = 0; b < 2; ++b)
#pragma unroll
                for (int m = 0; m < 4; ++m)
#pragma unroll
                    for (int n = 0; n < 2; ++n) acc[a][b][m][n] = (f32x4){0.f, 0.f, 0.f, 0.f};
        u32x4 ra[4], rb[4];
#pragma unroll
        for (int i = 0; i < 4; ++i) { ra[i] = *(const u32x4*)(Ag + (size_t)(64 * i) * K); rb[i] = *(const u32x4*)(Bg + (size_t)(64 * i) * K); }
        for (int t = 0; t < nt; ++t) {
            __syncthreads();
#pragma unroll
            for (int i = 0; i < 4; ++i) { *(PG8_LAS u32x4*)(As + (srow + 64 * i) * LSTR + sch * 16) = ra[i]; *(PG8_LAS u32x4*)(Bs + (srow + 64 * i) * LSTR + sch * 16) = rb[i]; }
            if (t + 1 < nt) {
#pragma unroll
                for (int i = 0; i < 4; ++i) { ra[i] = *(const u32x4*)(Ag + (size_t)(64 * i) * K + (t + 1) * BK); rb[i] = *(const u32x4*)(Bg + (size_t)(64 * i) * K + (t + 1) * BK); } }
            __syncthreads();
#pragma unroll
            for (int ai = 0; ai < 2; ++ai) {
                bf16x8 At[4][2];
#pragma unroll
                for (int m = 0; m < 4; ++m)
#pragma unroll
                    for (int k = 0; k < 2; ++k) At[m][k] = *(const PG8_LAS bf16x8*)(As + aoff + (ai * HALF + m * 16) * LSTR + k * 64);
#pragma unroll
                for (int bj = 0; bj < 2; ++bj) {
                    bf16x8 Bt[2][2];
#pragma unroll
                    for (int n = 0; n < 2; ++n)
#pragma unroll
                        for (int k = 0; k < 2; ++k) Bt[n][k] = *(const PG8_LAS bf16x8*)(Bs + boff[n] + bj * HALF * LSTR + k * 64);
#pragma unroll
                    for (int m = 0; m < 4; ++m)
#pragma unroll
                        for (int n = 0; n < 2; ++n)
#pragma unroll
                            for (int k = 0; k < 2; ++k) acc[ai][bj][m][n] = __builtin_amdgcn_mfma_f32_16x16x32_bf16(Bt[n][k], At[m][k], acc[ai][bj][m][n], 0, 0, 0);
                }
            }
        }
        E(acc, cur, wr, wc, fr, fq);
    }
    __syncthreads();
}
}
using pg8::ACT_LD; using pg8::GATE_LD; using pg8::MISC_LD; using pg8::VT_LD; using pg8::sigmoidf_;
#define GAS __attribute__((address_space(1)))
#define LAS __attribute__((address_space(3)))
typedef unsigned short bf16;
typedef unsigned v4u __attribute__((ext_vector_type(4)));
typedef unsigned v2u __attribute__((ext_vector_type(2)));
typedef float f32x4 __attribute__((ext_vector_type(4)));
typedef float f32x2 __attribute__((ext_vector_type(2)));
typedef float f32x16 __attribute__((ext_vector_type(16)));
typedef short bf16x8 __attribute__((ext_vector_type(8)));
typedef short s16x4 __attribute__((ext_vector_type(4)));
typedef GAS unsigned gu32;
typedef GAS unsigned long long gu64;
#define RLX_AGENT __ATOMIC_RELAXED, __HIP_MEMORY_SCOPE_AGENT
#define LDS_WAIT() asm volatile("s_waitcnt lgkmcnt(0)" ::: "memory")
#define VM_WAIT() asm volatile("s_waitcnt vmcnt(0)" ::: "memory")
__device__ __forceinline__ unsigned f2bf(float f) { unsigned u = __builtin_bit_cast(unsigned, f); return (u + 0x7fffu + ((u >> 16) & 1u)) >> 16; }
__device__ __forceinline__ unsigned pk2(float lo, float hi) { return f2bf(lo) | (f2bf(hi) << 16); }
__device__ __forceinline__ float bflo(unsigned w) { return __uint_as_float(w << 16); }
__device__ __forceinline__ float bfhi(unsigned w) { return __uint_as_float(w & 0xffff0000u); }
__device__ __forceinline__ float bf2f(bf16 h) { return __uint_as_float(((unsigned)h) << 16); }

#define XB_TMO      128
#define XB_XCNT(j)  (256  + 64 * (j))
#define XB_XSUB(j)  (1280 + 64 * (j))
#define XB_XGEN(j)  (2304 + 64 * (j))
#define XB_TOP      3328
#define XB_TOPGEN   3392
#define XCD_BAR_WORDS 3456
#define XB_SPIN_CAP (1u << 18)

__device__ __forceinline__ unsigned xb_ld(unsigned* p)              { return __hip_atomic_load(p, __ATOMIC_RELAXED, __HIP_MEMORY_SCOPE_AGENT); }
__device__ __forceinline__ unsigned xb_add(unsigned* p, unsigned v) { return __hip_atomic_fetch_add(p, v, __ATOMIC_RELAXED, __HIP_MEMORY_SCOPE_AGENT); }
__device__ __forceinline__ unsigned xb_xcc_id() { return (unsigned)__builtin_amdgcn_s_getreg((3 << 11) | 20) & 0xFu; }
#define XB_SPIN(cond, bar) do { unsigned _sp = 0; while (cond) { __builtin_amdgcn_s_sleep(1); \
    if ((++_sp & 255u) == 0u) { if (xb_ld(&(bar)[XB_TMO])) break; if (_sp > XB_SPIN_CAP) { atomicAdd(&(bar)[XB_TMO], 1u); break; } } } } while (0)

struct XcdBarrier {
    unsigned* bar; unsigned x;
    volatile LAS unsigned* st;
};

__device__ __forceinline__ XcdBarrier xcd_barrier_post(unsigned* bar, volatile LAS unsigned* st) {
    XcdBarrier b; b.bar = bar; b.x = xb_xcc_id(); b.st = st;
    if (threadIdx.x == 0) (void)xb_add(&bar[XB_XCNT(b.x)], 1u);
    return b;
}
__device__ __forceinline__ void xcd_barrier_complete(unsigned* bar, unsigned x, unsigned& nloc, unsigned& nx) {
    const unsigned G = gridDim.x * gridDim.y * gridDim.z;
    unsigned sum, cnt, mine, sp = 0u;
    for (;;) {
        sum = 0u; cnt = 0u; mine = 0u;
#pragma unroll
        for (unsigned j = 0; j < 16; ++j) { const unsigned c = xb_ld(&bar[XB_XCNT(j)]); sum += c; cnt += (c > 0u) ? 1u : 0u; mine = (j == x) ? c : mine; }
        if (sum == G) break;
        __builtin_amdgcn_s_sleep(1);
        if ((++sp & 255u) == 0u) { if (xb_ld(&bar[XB_TMO])) break; if (sp > XB_SPIN_CAP) { atomicAdd(&bar[XB_TMO], 1u); break; } }
    }
    nloc = mine > 0u ? mine : 1u; nx = cnt > 0u ? cnt : 1u;
}

__device__ __forceinline__ void xcd_barrier(const XcdBarrier& b) {
    asm volatile("s_waitcnt vmcnt(0)" ::: "memory");
    __syncthreads();
    if (threadIdx.x == 0) {
        unsigned* bar = b.bar;
        __builtin_amdgcn_s_waitcnt(0);
        unsigned nloc = b.st[0], nx = b.st[1];
        if (nloc == 0u) { xcd_barrier_complete(bar, b.x, nloc, nx); b.st[0] = nloc; b.st[1] = nx; }
        const unsigned old = xb_add(&bar[XB_XSUB(b.x)], 1u);
        const unsigned gen = old / nloc;
        if (old + 1u == (gen + 1u) * nloc) {
            __builtin_amdgcn_fence(__ATOMIC_RELEASE, "agent");
            asm volatile("s_waitcnt vmcnt(0)" ::: "memory");
            const unsigned og = xb_add(&bar[XB_TOP], 1u);
            const unsigned tg = og / nx;
            if (og + 1u == (tg + 1u) * nx) xb_add(&bar[XB_TOPGEN], 1u);
            else XB_SPIN(xb_ld(&bar[XB_TOPGEN]) == tg, bar);
            __builtin_amdgcn_fence(__ATOMIC_ACQUIRE, "agent");
            xb_add(&bar[XB_XGEN(b.x)], 1u);
            asm volatile("s_waitcnt vmcnt(0)" ::: "memory");
        } else {
            XB_SPIN(xb_ld(&bar[XB_XGEN(b.x)]) == gen, bar);
            __builtin_amdgcn_fence(__ATOMIC_ACQUIRE, "agent");
            asm volatile("s_waitcnt vmcnt(0)" ::: "memory");
        }
    }
    __syncthreads();
}
constexpr int NWAVES = 8, NTHR = 512;
constexpr int NB = 4, SEQ = 2048, NTOK = 8192, DM = 2048, NHEAD = 8, HDIM = 64, NLAYER = 2;
constexpr int NWIN = 13568, NWIN_SRC = 13376;
constexpr float RMS_EPS = 1e-6f, LOG2E = 1.4426950408889634f;
constexpr int C_FQ = 0, C_FK = 512, C_MCQ = 1536, C_MCKV = 2048, C_NQ = 2304, C_NKC = 2816, C_NVC = 2944, C_NKS = 3072, C_NKW = 3328, C_SQ = 3584, C_SK = 4096;
constexpr int R_FV = 0, R_SV = 512, R_NVS = 1024, R_NVW = 1152, R_MV = 1280, VT_ROWS = 1792;

constexpr size_t MiB = 1u << 20;
constexpr size_t WS_CTL = 0, CTL_ZERO_BYTES = 1 * MiB;
constexpr size_t LW_WIN = 0;
constexpr size_t LW_WUQ = LW_WIN + (size_t)NWIN * 2048;
constexpr size_t LW_WUKV = LW_WUQ + (size_t)768 * 512 * 2;
constexpr size_t LW_KCW1 = LW_WUKV + (size_t)1024 * 256 * 2;
constexpr size_t LW_VCW1 = LW_KCW1 + (size_t)256 * 2048 * 2;
constexpr size_t LW_KCW2 = LW_VCW1 + (size_t)256 * 2048 * 2;
constexpr size_t LW_VCW2 = LW_KCW2 + (size_t)256 * 256 * 2;
constexpr size_t LW_WBR = LW_VCW2 + (size_t)256 * 256 * 2;
constexpr size_t LW_WOUT = LW_WBR + (size_t)8192 * 512 * 2;
constexpr size_t LW_WQ = LW_WOUT + (size_t)2048 * 2048 * 2;
constexpr size_t LW_SK1 = LW_WQ + (size_t)2048 * 2048 * 2;
constexpr size_t LW_SK2 = LW_SK1 + (size_t)8 * 128 * 128 * 2;
constexpr size_t LW_U = LW_SK2 + (size_t)8 * 128 * 128 * 2;
constexpr size_t LW_V = LW_U + (size_t)16384 * 2048;
constexpr size_t LW_SU = LW_V + (size_t)16384 * 2048;
constexpr size_t LW_SV = LW_SU + (size_t)16384 * 4;
constexpr size_t LW_SWIN = LW_SV + (size_t)16384 * 4;
constexpr size_t LW_SWQ = LW_SWIN + (size_t)NWIN * 4;
constexpr size_t LW_WQB = LW_SWQ + (size_t)2048 * 4;
constexpr size_t LW_BYTES = LW_WQB + (size_t)2048 * 2048 * 2;
constexpr size_t WS_W = 1 * MiB;
constexpr size_t WS_A0 = WS_W + NLAYER * LW_BYTES;
constexpr size_t WS_HN = WS_A0;
constexpr size_t WS_ACT = WS_HN + (size_t)NTOK * 2048 * 2;
constexpr size_t WS_ZF = WS_ACT;
constexpr size_t WS_GATE = WS_ACT + (size_t)NTOK * 5376 * 2;
constexpr size_t WS_MISC = WS_GATE + (size_t)NTOK * 8192 * 2;
constexpr size_t WS_VT = WS_MISC + (size_t)NTOK * 64 * 4;
constexpr size_t WS_EIDX = WS_VT, WS_EGATE = WS_VT + (size_t)NTOK * 128 * 4;
constexpr size_t WS_FCUM = WS_VT + (size_t)VT_ROWS * NTOK * 2;
constexpr size_t WS_CQN = WS_FCUM + (size_t)32 * 2048 * 4 + 256;
constexpr size_t WS_CKVN = WS_CQN + (size_t)NTOK * 512 * 2;
constexpr size_t WS_QM = WS_CKVN + (size_t)NTOK * 256 * 2;
constexpr size_t WS_KM = WS_QM + (size_t)NTOK * 768 * 2;
constexpr size_t WS_ABK = WS_KM + (size_t)NTOK * 768 * 2;
constexpr size_t WS_ABV = WS_ABK + (size_t)1024 * 2048 * 2;
constexpr size_t WS_HK = WS_ABV + (size_t)1024 * 2048 * 2;
constexpr size_t WS_HV = WS_HK + (size_t)1024 * 256 * 2;
constexpr size_t WS_KC = WS_HV + (size_t)1024 * 256 * 2;
constexpr size_t WS_VCT = WS_KC + (size_t)8 * 128 * 64 * 2;
constexpr size_t WS_BR = WS_VCT + (size_t)8 * 64 * 128 * 2;
constexpr size_t WS_QP = WS_BR;
constexpr size_t WS_Z = WS_BR + (size_t)4 * NTOK * 512 * 2;
constexpr size_t WS_XA = WS_Z + (size_t)NTOK * 2048 * 2;
constexpr size_t WS_XB = WS_XA + (size_t)NTOK * 2048 * 4;
constexpr size_t WS_R16 = WS_XB + (size_t)NTOK * 2048 * 4;
constexpr size_t WS_R32 = WS_R16 + (size_t)2048 * 8 * 2 * 4;
constexpr size_t WS_HN8 = WS_R32 + (size_t)2048 * 16 * 2 * 4;
constexpr size_t WS_SXH = WS_HN8 + (size_t)NTOK * 2048;
constexpr size_t WS_END = WS_SXH + (size_t)NTOK * 4;
static_assert(WS_END <= (size_t)1024 * MiB, "workspace map must fit 1 GiB");
static_assert((size_t)NTOK * 2048 * 4 <= (size_t)NTOK * 5376 * 2, "ZF overlay");
constexpr int CW_TMO = 0, CW_BAR = 4096, CW_COLMAX = 65536, CM_LAYER = 13568 + 2048, CW_FOXN = 131072, CW_NSAF = 139264;

constexpr int RING_OFF = 0, RING_BYTES = 131072;
constexpr int LDSCTL_OFF = RING_BYTES, MISC_OFF = LDSCTL_OFF + 320;
constexpr int LDS_BYTES = 147456;
struct Frame {
    LAS unsigned char* lds;
    volatile LAS unsigned* MISCW;
    gu32* ctl;
    int tid, lane, wave, vcu, G;
    unsigned char* ws;
    float* out;
};
__device__ __forceinline__ float wave_sum(float v) {
#pragma unroll
    for (int o = 1; o < 64; o <<= 1) v += __shfl_xor(v, o);
    return v;
}
__device__ __forceinline__ int win_src_col(int d) {
    if (d < 1536) return d;
    if (d < 2304) return 1544 + (d - 1536);
    if (d < 3584) { const int o = d - 2304; int src = 2344 + o;
        const bool il = (o < 512) || (o >= 768 && o < 896) || (o >= 1024 && o < 1152);
        if (il) { const int hl = o & 63; if (hl < 16) src = 2344 + (o & ~63) + (hl >> 1) + 8 * (hl & 1); }
        return src; }
    if (d < 5120) return 3648 + (d - 3584);
    if (d < 5128) return 1536 + (d - 5120);
    if (d < 5160) return 2312 + (d - 5128);
    if (d < 5184) return 3624 + (d - 5160);
    if (d < 5376) return -1;
    return 5184 + (d - 5376);
}
__device__ __forceinline__ int map_col(int map, int n, int Nsrc) {
    if (map == 1) return win_src_col(n);
    if (map == 2) { const int hh = (n & 511) >> 6, d = n & 63; return hh * 128 + (n >= 512 ? 64 : 0) + d; }
    if (map == 3) { if (n >= 64) return -1; return n < 16 ? (n >> 1) + 8 * (n & 1) : n; }
    return n < Nsrc ? n : -1;
}
struct TrSrc { const float* W; int K, Nsrc; bf16* WT; int Ndst, map, sliced, item; };
__device__ __forceinline__ int tr_load(const TrSrc& t, int lane, float (&tv)[32]) {
    const int nblk = t.Ndst / 32, kb = t.item / nblk, nb = t.item % nblk, k0 = 64 * kb, n0 = 32 * nb;
    const int sc = map_col(t.map, n0 + (lane & 31), t.Nsrc); const float* wp = t.W + (size_t)(k0 + (lane >> 5)) * t.Nsrc + (sc >= 0 ? sc : 0);
#pragma unroll
    for (int i = 0; i < 32; ++i) tv[i] = wp[(size_t)(2 * i) * t.Nsrc];
    return sc;
}
__device__ __forceinline__ void tr_finish(const TrSrc& t, int sc, const float (&tv)[32], LAS float* scr, int lane) {
    const int nblk = t.Ndst / 32, kb = t.item / nblk, nb = t.item % nblk, k0 = 64 * kb, n0 = 32 * nb;
#pragma unroll
    for (int i = 0; i < 32; ++i) { const int kk = 2 * i + (lane >> 5); scr[kk * 33 + (lane & 31)] = (sc >= 0) ? tv[i] : 0.f; }
    LDS_WAIT(); asm volatile("" ::: "memory");
    const int c = lane & 7;
#pragma unroll
    for (int j = 0; j < 4; ++j) { const int n = (lane >> 3) + 8 * j; const LAS float* s = scr + (8 * c) * 33 + n;
        v4u o; o.x = pk2(s[0 * 33], s[1 * 33]); o.y = pk2(s[2 * 33], s[3 * 33]); o.z = pk2(s[4 * 33], s[5 * 33]); o.w = pk2(s[6 * 33], s[7 * 33]);
        bf16* dp = t.sliced ? t.WT + (size_t)(k0 >> 9) * t.Ndst * 512 + (size_t)(n0 + n) * 512 + (k0 & 511) + 8 * c : t.WT + (size_t)(n0 + n) * t.K + k0 + 8 * c;
        *(GAS v4u*)dp = o; }
    LDS_WAIT(); asm volatile("" ::: "memory");
}
__device__ __forceinline__ void rms_row_to_bf16(int lane, const float* xrow, const float* gain, bf16* orow, signed char* o8 = nullptr, float* sx = nullptr) {
    f32x4 v[8]; float s = 0.f;
#pragma unroll
    for (int j = 0; j < 8; ++j) { v[j] = *((const f32x4*)xrow + lane + 64 * j); s += (v[j].x * v[j].x + v[j].y * v[j].y) + (v[j].z * v[j].z + v[j].w * v[j].w); }
    const float rstd = 1.0f / sqrtf(wave_sum(s) * (1.f / 2048.f) + RMS_EPS); float am = 0.f;
    f32x4 g[8];
#pragma unroll
    for (int j = 0; j < 8; ++j) g[j] = *((const f32x4*)gain + lane + 64 * j);
#pragma unroll
    for (int j = 0; j < 8; ++j) { v[j] = v[j] * rstd * g[j];
        v2u o; o.x = pk2(v[j].x, v[j].y); o.y = pk2(v[j].z, v[j].w);
        *((v2u*)orow + lane + 64 * j) = o; am = fmaxf(am, fmaxf(fmaxf(fabsf(v[j].x), fabsf(v[j].y)), fmaxf(fabsf(v[j].z), fabsf(v[j].w)))); }
    if (o8) {
#pragma unroll
        for (int o = 1; o < 64; o <<= 1) am = fmaxf(am, __shfl_xor(am, o));
        am = fmaxf(am, 1e-30f); const float sc = 127.0f / am;
#pragma unroll
        for (int j = 0; j < 8; ++j) { const int q0 = __float2int_rn(v[j].x * sc), q1 = __float2int_rn(v[j].y * sc), q2 = __float2int_rn(v[j].z * sc), q3 = __float2int_rn(v[j].w * sc);
            *((unsigned*)o8 + lane + 64 * j) = (unsigned)(q0 & 255) | ((unsigned)(q1 & 255) << 8) | ((unsigned)(q2 & 255) << 16) | ((unsigned)(q3 & 255) << 24); }
        if (lane == 0) *sx = am * (1.0f / 127.0f); }
}
__device__ __forceinline__ int win_dst_row(int s) {
    if (s < 1536) return s;
    if (s < 1544) return 5120 + (s - 1536);
    if (s < 2312) return 1536 + (s - 1544);
    if (s < 2344) return 5128 + (s - 2312);
    if (s < 3624) { const int o = s - 2344; const bool il = (o < 512) || (o >= 768 && o < 896) || (o >= 1024 && o < 1152); const int hl = o & 63;
        if (il && hl < 16) return 2304 + (o & ~63) + 2 * (hl & 7) + (hl >> 3);
        return 2304 + o; }
    if (s < 3648) return 5160 + (s - 3624);
    if (s < 5184) return 3584 + (s - 3648);
    return 5376 + (s - 5184);
}
struct Q8Src { const float* W; int Nsrc, map, item; signed char* WT; float* sw; };
__device__ __forceinline__ void q8_load(const Q8Src& q, int tid, f32x4 (&v)[8][4]) {
    const int cg = tid & 7, rl = tid >> 3; const float* wp = q.W + (size_t)(4 * rl) * q.Nsrc + 32 * q.item + 4 * cg;
#pragma unroll
    for (int j = 0; j < 8; ++j)
#pragma unroll
        for (int r = 0; r < 4; ++r) v[j][r] = *(const f32x4*)(wp + (size_t)(256 * j + r) * q.Nsrc);
}
__device__ __forceinline__ void q8_item(const Q8Src& q, const Q8Src& qn, bool has_next, LAS unsigned char* lds, int tid, f32x4 (&v)[8][4]) {
    constexpr int LDT = 2064;
    const int s0 = 32 * q.item, cg = tid & 7, rl = tid >> 3, lane = tid & 63, wave = tid >> 6;
    f32x4 am = {0.f, 0.f, 0.f, 0.f};
#pragma unroll
    for (int j = 0; j < 8; ++j)
#pragma unroll
        for (int r = 0; r < 4; ++r)
#pragma unroll
            for (int c = 0; c < 4; ++c) am[c] = fmaxf(am[c], fabsf(v[j][r][c]));
#pragma unroll
    for (int c = 0; c < 4; ++c) { am[c] = fmaxf(am[c], __shfl_xor(am[c], 8)); am[c] = fmaxf(am[c], __shfl_xor(am[c], 16)); am[c] = fmaxf(am[c], __shfl_xor(am[c], 32)); }
    LAS float* red = (LAS float*)(lds + 32 * LDT);
    if (lane < 8) *(LAS f32x4*)(red + wave * 32 + 4 * cg) = am;
    __syncthreads();
    f32x4 cm = *(const LAS f32x4*)(red + 4 * cg);
#pragma unroll
    for (int w = 1; w < 8; ++w) { const f32x4 t = *(const LAS f32x4*)(red + w * 32 + 4 * cg); cm[0] = fmaxf(cm[0], t[0]); cm[1] = fmaxf(cm[1], t[1]); cm[2] = fmaxf(cm[2], t[2]); cm[3] = fmaxf(cm[3], t[3]); }
    f32x4 inv;
#pragma unroll
    for (int c = 0; c < 4; ++c) { cm[c] = fmaxf(cm[c], 1e-30f); inv[c] = 127.0f / cm[c]; }
#pragma unroll
    for (int j = 0; j < 8; ++j)
#pragma unroll
        for (int c = 0; c < 4; ++c) { unsigned d = 0;
#pragma unroll
            for (int r = 0; r < 4; ++r) d |= (unsigned)(__float2int_rn(v[j][r][c] * inv[c]) & 255) << (8 * r);
            *(LAS unsigned*)(lds + (4 * cg + c) * LDT + 4 * rl + 256 * j) = d; }
    if (has_next) q8_load(qn, tid, v);
    __syncthreads();
#pragma unroll
    for (int i = 0; i < 8; ++i) { const int pidx = tid + 512 * i, row = pidx >> 7, o = (pidx & 127) * 16; const int drow = q.map ? win_dst_row(s0 + row) : s0 + row;
        *(v4u*)(q.WT + (size_t)drow * 2048 + o) = *(const LAS v4u*)(lds + row * LDT + o); }
    if (tid < 8) {
#pragma unroll
        for (int c = 0; c < 4; ++c) { const int drow = q.map ? win_dst_row(s0 + 4 * cg + c) : s0 + 4 * cg + c; q.sw[drow] = cm[c] * (1.0f / 127.0f); } }
    __syncthreads();
}
template <bool BF> __device__ __forceinline__ void rms_rows(int lane, const void* X, const float* gain, bf16* O, signed char* O8, float* SX, int m0, int step, int M) {
    f32x4 g[8];
#pragma unroll
    for (int j = 0; j < 8; ++j) g[j] = *((const f32x4*)gain + lane + 64 * j);
    v2u rb[8]; f32x4 rf[8];
#define RR_LOAD(m) { _Pragma("unroll") for (int j = 0; j < 8; ++j) { if (BF) rb[j] = *((const v2u*)((const bf16*)X + (size_t)(m) * 2048) + lane + 64 * j); else rf[j] = *((const f32x4*)((const float*)X + (size_t)(m) * 2048) + lane + 64 * j); } }
    if (m0 < M) RR_LOAD(m0)
#pragma nounroll
    for (int m = m0; m < M; m += step) { f32x4 v[8]; float s = 0.f;
#pragma unroll
        for (int j = 0; j < 8; ++j) { if (BF) v[j] = (f32x4){bflo(rb[j].x), bfhi(rb[j].x), bflo(rb[j].y), bfhi(rb[j].y)}; else v[j] = rf[j]; s += (v[j].x * v[j].x + v[j].y * v[j].y) + (v[j].z * v[j].z + v[j].w * v[j].w); }
        if (m + step < M) RR_LOAD(m + step)
        const float rstd = 1.0f / sqrtf(wave_sum(s) * (1.f / 2048.f) + RMS_EPS); float am = 0.f;
        bf16* orow = O + (size_t)m * 2048; signed char* o8 = O8 + (size_t)m * 2048;
#pragma unroll
        for (int j = 0; j < 8; ++j) { v[j] = v[j] * rstd * g[j];
            v2u o; o.x = pk2(v[j].x, v[j].y); o.y = pk2(v[j].z, v[j].w);
            *((v2u*)orow + lane + 64 * j) = o; am = fmaxf(am, fmaxf(fmaxf(fabsf(v[j].x), fabsf(v[j].y)), fmaxf(fabsf(v[j].z), fabsf(v[j].w)))); }
#pragma unroll
        for (int o = 1; o < 64; o <<= 1) am = fmaxf(am, __shfl_xor(am, o));
        am = fmaxf(am, 1e-30f); const float sc = 127.0f / am;
#pragma unroll
        for (int j = 0; j < 8; ++j) { const int q0 = __float2int_rn(v[j].x * sc), q1 = __float2int_rn(v[j].y * sc), q2 = __float2int_rn(v[j].z * sc), q3 = __float2int_rn(v[j].w * sc);
            *((unsigned*)o8 + lane + 64 * j) = (unsigned)(q0 & 255) | ((unsigned)(q1 & 255) << 8) | ((unsigned)(q2 & 255) << 16) | ((unsigned)(q3 & 255) << 24); }
        if (lane == 0) SX[m] = am * (1.0f / 127.0f); }
#undef RR_LOAD
}
__device__ __forceinline__ void conv_plain(const float* src, bf16* dst, size_t n, size_t gtid, size_t gthreads) {
    for (size_t i = gtid * 8; i < n; i += gthreads * 8) { const f32x4 a = *(const f32x4*)(src + i), b = *(const f32x4*)(src + i + 4);
        v4u o; o.x = pk2(a.x, a.y); o.y = pk2(a.z, a.w); o.z = pk2(b.x, b.y); o.w = pk2(b.z, b.w); *(v4u*)(dst + i) = o; }
}
template <class A> __device__ __forceinline__ void p0_prologue(Frame& F, const A& args) {
    LAS float* scr = (LAS float*)(F.lds + RING_OFF + F.wave * 16384);
    const int gw = F.vcu * NWAVES + F.wave, NGW = F.G * NWAVES;
    constexpr int IT_WIN = 32 * (NWIN / 32), IT_UQ = 8 * 24, IT_UKV = 4 * 32, IT_W1 = 32 * 8, IT_W2 = 4 * 8, IT_BR = 8 * 64, IT_SQ = 32 * 64;
    constexpr int IT_LAYER = IT_UQ + IT_UKV + 2 * IT_W1 + 2 * IT_W2 + 4 * IT_BR + IT_SQ;
    auto tr_decode = [&](int it) -> TrSrc {
        const int l = it / IT_LAYER; int r = it % IT_LAYER; unsigned char* lw = F.ws + WS_W + (size_t)l * LW_BYTES;
        if (r < IT_UQ) return TrSrc{args.in[6] + (size_t)l * 512 * 768, 512, 768, (bf16*)(lw + LW_WUQ), 768, 0, 0, r}; r -= IT_UQ;
        if (r < IT_UKV) return TrSrc{args.in[7] + (size_t)l * 256 * 1024, 256, 1024, (bf16*)(lw + LW_WUKV), 1024, 2, 0, r}; r -= IT_UKV;
        if (r < IT_W1) return TrSrc{args.in[9] + (size_t)l * 2048 * 256, 2048, 256, (bf16*)(lw + LW_KCW1), 256, 0, 1, r}; r -= IT_W1;
        if (r < IT_W1) return TrSrc{args.in[12] + (size_t)l * 2048 * 256, 2048, 256, (bf16*)(lw + LW_VCW1), 256, 0, 1, r}; r -= IT_W1;
        if (r < IT_W2) return TrSrc{args.in[10] + (size_t)l * 256 * 64, 256, 64, (bf16*)(lw + LW_KCW2), 256, 3, 0, r}; r -= IT_W2;
        if (r < IT_W2) return TrSrc{args.in[13] + (size_t)l * 256 * 64, 256, 64, (bf16*)(lw + LW_VCW2), 256, 0, 0, r}; r -= IT_W2;
        if (r < 4 * IT_BR) { const int n = r / IT_BR; return TrSrc{args.in[14] + ((size_t)l * 4 + n) * 512 * 2048, 512, 2048, (bf16*)(lw + LW_WBR) + (size_t)n * 2048 * 512, 2048, 0, 0, r % IT_BR}; } r -= 4 * IT_BR;
        return TrSrc{args.in[15] + (size_t)l * 2048 * 2048, 2048, 2048, (bf16*)(lw + LW_WOUT), 2048, 0, 0, r}; };
    if (gw < NLAYER * IT_LAYER) { float tv[32]; TrSrc tc = tr_decode(gw); int sc = tr_load(tc, F.lane, tv);
#pragma nounroll
        for (int it = gw; it < NLAYER * IT_LAYER; it += NGW) { const bool has_next = it + NGW < NLAYER * IT_LAYER; const TrSrc tn = tr_decode(has_next ? it + NGW : it);
            float tc_v[32];
#pragma unroll
            for (int i = 0; i < 32; ++i) tc_v[i] = tv[i];
            const int sc_c = sc; if (has_next) sc = tr_load(tn, F.lane, tv);
            tr_finish(tc, sc_c, tc_v, scr, F.lane); tc = tn; } }
    const size_t gtid = (size_t)F.vcu * NTHR + F.tid, gthreads = (size_t)F.G * NTHR;
    for (int l = 0; l < NLAYER; ++l) { unsigned char* lw = F.ws + WS_W + (size_t)l * LW_BYTES;
        conv_plain(args.in[18] + (size_t)l * 131072, (bf16*)(lw + LW_SK1), 131072, gtid, gthreads);
        conv_plain(args.in[19] + (size_t)l * 131072, (bf16*)(lw + LW_SK2), 131072, gtid, gthreads);
    }
#define UV_SRC(r) (args.in[20 + (((r) >> 14) & 1)] + ((size_t)((r) >> 15) * 16384 + ((r) & 16383)) * 2048 + 32 * F.lane)
    { f32x4 v[8];
      if (gw < NLAYER * 2 * 16384) { const float* src = UV_SRC(gw);
#pragma unroll
          for (int j = 0; j < 8; ++j) v[j] = *((const f32x4*)src + j); }
#pragma nounroll
      for (int r = gw; r < NLAYER * 2 * 16384; r += NGW) { const int l = r >> 15, tb = (r >> 14) & 1, e = r & 16383; unsigned char* lw = F.ws + WS_W + (size_t)l * LW_BYTES;
        float am = 0.f; f32x4 c[8];
#pragma unroll
        for (int j = 0; j < 8; ++j) { c[j] = v[j]; am = fmaxf(am, fmaxf(fmaxf(fabsf(c[j].x), fabsf(c[j].y)), fmaxf(fabsf(c[j].z), fabsf(c[j].w)))); }
        if (r + NGW < NLAYER * 2 * 16384) { const float* src = UV_SRC(r + NGW);
#pragma unroll
            for (int j = 0; j < 8; ++j) v[j] = *((const f32x4*)src + j); }
#pragma unroll
        for (int o = 1; o < 64; o <<= 1) am = fmaxf(am, __shfl_xor(am, o));
        am = fmaxf(am, 1e-30f); const float sc = 7.0f / am;
        unsigned pk[7] = {0u, 0u, 0u, 0u, 0u, 0u, 0u};
#pragma unroll
        for (int i = 0; i < 32; ++i) { const float x = c[i >> 2][i & 3] * sc, ax = fabsf(x);
            int cd = ax < 2.0f ? __float2int_rn(ax * 8.0f) : ax < 4.0f ? 16 + __float2int_rn((ax - 2.0f) * 4.0f) : 24 + __float2int_rn((ax - 4.0f) * 2.0f); cd = cd > 31 ? 31 : cd;
            const unsigned code = (unsigned)cd | (x < 0.f ? 32u : 0u); const int bp = 6 * i, wd = bp >> 5, sh = bp & 31;
            pk[wd] |= code << sh; if (sh > 26) pk[wd + 1] |= code >> (32 - sh); }
        v2u* dst = (v2u*)(lw + (tb ? LW_V : LW_U) + ((size_t)(F.lane >> 3) * 16384 + e) * 192 + 24 * (F.lane & 7));     dst[0] = (v2u){pk[0], pk[1]}; dst[1] = (v2u){pk[2], pk[3]}; dst[2] = (v2u){pk[4], pk[5]};
        if (F.lane == 0) ((float*)(lw + (tb ? LW_SV : LW_SU)))[e] = am * (1.0f / 7.0f);
      } }
#undef UV_SRC
    for (size_t i = gtid; i < 2048 * 24; i += gthreads) { const int pos = (int)(i / 24), k = (int)(i % 24); const int half = k < 8 ? 8 : 16, idx = k < 8 ? k : k - 8;
        const float a = (-13.122363377404328f * (float)idx) / (float)half; const float inv = expf(a); const float ang = (float)pos * inv;
        const double x = (double)ang; const double nn = rint(x * 0.15915494309189535); const float rr = (float)(x - nn * 6.283185307179586);
        float* dst = (k < 8) ? (float*)(F.ws + WS_R16) + ((size_t)pos * 8 + idx) * 2 : (float*)(F.ws + WS_R32) + ((size_t)pos * 16 + idx) * 2;
        dst[0] = cosf(rr); dst[1] = sinf(rr); }
    for (size_t i = gtid; i < 4 * 8 * 512 / 2; i += gthreads) { const size_t s = i / (8 * 256), w = i % (8 * 256); const size_t o = (s * 1024 + 1016) * 256 + w;
        ((unsigned*)(F.ws + WS_ABK))[o] = 0u; ((unsigned*)(F.ws + WS_ABV))[o] = 0u; }
    for (size_t i = gtid; i < 2 * 8 * 128 * 64 / 2; i += gthreads) ((unsigned*)(F.ws + WS_KC))[i] = 0u;
    rms_rows<false>(F.lane, args.in[0], args.in[1], (bf16*)(F.ws + WS_HN), (signed char*)(F.ws + WS_HN8), (float*)(F.ws + WS_SXH), gw, NGW, NTOK);
    for (int l = 0; l < NLAYER; ++l) { unsigned char* lw = F.ws + WS_W + (size_t)l * LW_BYTES;
        for (size_t i = gtid; i < (size_t)192 * 2048 / 4; i += gthreads) ((unsigned*)(lw + LW_WIN + (size_t)5184 * 2048))[i] = 0u;
        for (size_t i = gtid; i < 192; i += gthreads) ((float*)(lw + LW_SWIN))[5184 + i] = 0.f; }
}
template <class A> __device__ __forceinline__ Q8Src q8_decode(Frame& F, const A& args, int it) {
    constexpr int QI_WIN = NWIN_SRC / 32, QI_WQ = 64, QI_LAYER = QI_WIN + QI_WQ; const int l = it / QI_LAYER, r = it % QI_LAYER; unsigned char* lw = F.ws + WS_W + (size_t)l * LW_BYTES;
    if (r < QI_WIN) return Q8Src{args.in[2] + (size_t)l * 2048 * NWIN_SRC, NWIN_SRC, 1, r, (signed char*)(lw + LW_WIN), (float*)(lw + LW_SWIN)};
    return Q8Src{args.in[17] + (size_t)l * 2048 * 2048, 2048, 0, r - QI_WIN, (signed char*)(lw + LW_WQ), (float*)(lw + LW_SWQ)};
}
template <class A> __device__ __forceinline__ void p0_int8_weights(Frame& F, const A& args) {
    constexpr int QI_TOTAL = NLAYER * (NWIN_SRC / 32 + 64);
    f32x4 v[8][4]; int it = F.vcu; if (it >= QI_TOTAL) return;
    Q8Src q = q8_decode(F, args, it); q8_load(q, F.tid, v);
#pragma nounroll
    for (; it < QI_TOTAL; it += F.G) { const bool has_next = it + F.G < QI_TOTAL; const Q8Src qn = q8_decode(F, args, has_next ? it + F.G : it);
        q8_item(q, qn, has_next, F.lds + RING_OFF, F.tid, v); q = qn; }
}
__device__ __forceinline__ float logsigmoidf_(float x) { return fminf(x, 0.f) - __logf(1.0f + __expf(-fabsf(x))); }
template <class A> __device__ __forceinline__ void p2_fox(Frame& F, const A& args, int l) {
    const int gw = F.vcu * NWAVES + F.wave, NGW = F.G * NWAVES, lane = F.lane;
    const float* MISC = (const float*)(F.ws + WS_MISC); const bf16* ACT = (const bf16*)(F.ws + WS_ACT);
    if (gw >= NGW - 32) { const int bhw = gw - (NGW - 32); const int b = bhw >> 3, h = bhw & 7; const float bias = args.in[3][l * 8 + h]; float loc[32]; float run = 0.f;
#pragma unroll
        for (int i = 0; i < 32; ++i) { const int s = lane * 32 + i; run += logsigmoidf_(MISC[(size_t)(b * SEQ + s) * 64 + h] + bias); loc[i] = run; }
        float inc = run;
#pragma unroll
        for (int o = 1; o < 64; o <<= 1) { const float t = __shfl_up(inc, o); if (lane >= o) inc += t; }
        const float base = inc - run; float* Fo = (float*)(F.ws + WS_FCUM) + (size_t)bhw * SEQ + lane * 32;
#pragma unroll
        for (int i = 0; i < 32; ++i) Fo[i] = base + loc[i]; }
    for (int task = gw; task < 32 * 32; task += NGW) { const int bh = task >> 5, b = bh >> 3, h = bh & 7; const bf16* rowp = ACT + (size_t)(b * SEQ + (task & 31) * 64 + lane) * ACT_LD + h * 64; float qs = 0.f, ks = 0.f;
#pragma unroll
        for (int c = 0; c < 8; ++c) { const v4u qw = *(const v4u*)(rowp + C_FQ + c * 8), kw = *(const v4u*)(rowp + C_FK + c * 8);
            qs += bflo(qw.x) * bflo(qw.x) + bfhi(qw.x) * bfhi(qw.x) + bflo(qw.y) * bflo(qw.y) + bfhi(qw.y) * bfhi(qw.y) + bflo(qw.z) * bflo(qw.z) + bfhi(qw.z) * bfhi(qw.z) + bflo(qw.w) * bflo(qw.w) + bfhi(qw.w) * bfhi(qw.w);
            ks += bflo(kw.x) * bflo(kw.x) + bfhi(kw.x) * bfhi(kw.x) + bflo(kw.y) * bflo(kw.y) + bfhi(kw.y) * bfhi(kw.y) + bflo(kw.z) * bflo(kw.z) + bfhi(kw.z) * bfhi(kw.z) + bflo(kw.w) * bflo(kw.w) + bfhi(kw.w) * bfhi(kw.w); }
#pragma unroll
        for (int o = 1; o < 64; o <<= 1) { qs = fmaxf(qs, __shfl_xor(qs, o)); ks = fmaxf(ks, __shfl_xor(ks, o)); }
        if (lane == 0) { unsigned* nb = (unsigned*)(F.ctl + CW_FOXN) + l * 64 + bh * 2; atomicMax(nb, __float_as_uint(qs)); atomicMax(nb + 1, __float_as_uint(ks)); } }
}
template <class A> __device__ __forceinline__ void p2_q_rows(Frame& F, const A& args, int l, int tb) {
    const int lane = F.lane; const f32x4 g0 = *(const f32x4*)(args.in[4] + l * 512 + lane * 8), g1 = *(const f32x4*)(args.in[4] + l * 512 + lane * 8 + 4);
    v4u nx[8];
#define PQ_LOAD(r0) { _Pragma("unroll") for (int u = 0; u < 8; ++u) nx[u] = *(const v4u*)((const bf16*)(F.ws + WS_ACT) + (size_t)(tb + 32 * F.wave + (r0) + u) * ACT_LD + C_MCQ + lane * 8); }
    PQ_LOAD(0)
#pragma nounroll
    for (int r0 = 0; r0 < 32; r0 += 8) { v4u wq[8]; float s1[8];
#pragma unroll
        for (int u = 0; u < 8; ++u) wq[u] = nx[u];
#pragma unroll
        for (int u = 0; u < 8; ++u) { const v4u w = wq[u]; const float x[8] = {bflo(w.x), bfhi(w.x), bflo(w.y), bfhi(w.y), bflo(w.z), bfhi(w.z), bflo(w.w), bfhi(w.w)}; float s = 0.f;
#pragma unroll
            for (int i = 0; i < 8; ++i) s += x[i] * x[i];
            s1[u] = s; }
        if (r0 < 24) PQ_LOAD(r0 + 8)
#pragma unroll
        for (int o = 1; o < 64; o <<= 1) {
#pragma unroll
            for (int u = 0; u < 8; ++u) s1[u] += __shfl_xor(s1[u], o); }
#pragma unroll
        for (int u = 0; u < 8; ++u) { const int t = tb + 32 * F.wave + r0 + u; const float r1 = 1.0f / sqrtf(s1[u] * (1.f / 512.f) + RMS_EPS);
            const v4u w = wq[u]; const float x[8] = {bflo(w.x), bfhi(w.x), bflo(w.y), bfhi(w.y), bflo(w.z), bfhi(w.z), bflo(w.w), bfhi(w.w)};
            v4u o; o.x = pk2(x[0] * r1 * g0.x, x[1] * r1 * g0.y); o.y = pk2(x[2] * r1 * g0.z, x[3] * r1 * g0.w); o.z = pk2(x[4] * r1 * g1.x, x[5] * r1 * g1.y); o.w = pk2(x[6] * r1 * g1.z, x[7] * r1 * g1.w);
            *(v4u*)((bf16*)(F.ws + WS_CQN) + (size_t)t * 512 + lane * 8) = o; } }
#undef PQ_LOAD
}
template <class A> __device__ __forceinline__ void p2_kv_rows(Frame& F, const A& args, int l, int tb, int rope) {
    const int lane = F.lane; const f32x4 gk = *(const f32x4*)(args.in[5] + l * 256 + lane * 4); const int i16 = lane & 15, hq = lane >> 4;
    const float* MISC = (const float*)(F.ws + WS_MISC); const float* R32 = (const float*)(F.ws + WS_R32);
    v2u nx[8]; float nr[8][4];
#define PK_LOAD(r0) { _Pragma("unroll") for (int u = 0; u < 8; ++u) { const int t = tb + 32 * F.wave + (r0) + u; nx[u] = *(const v2u*)((const bf16*)(F.ws + WS_ACT) + (size_t)t * ACT_LD + C_MCKV + lane * 4); \
        if (rope) { const int pos = t & (SEQ - 1); nr[u][0] = MISC[(size_t)t * 64 + 8 + i16]; nr[u][1] = MISC[(size_t)t * 64 + 24 + i16]; nr[u][2] = R32[((size_t)pos * 16 + i16) * 2]; nr[u][3] = R32[((size_t)pos * 16 + i16) * 2 + 1]; } } }
    PK_LOAD(0)
#pragma nounroll
    for (int r0 = 0; r0 < 32; r0 += 8) { v2u wk[8]; float s2[8], rr[8][4];
#pragma unroll
        for (int u = 0; u < 8; ++u) { wk[u] = nx[u];
#pragma unroll
            for (int i = 0; i < 4; ++i) rr[u][i] = nr[u][i]; }
#pragma unroll
        for (int u = 0; u < 8; ++u) { const v2u w2 = wk[u]; const float y[4] = {bflo(w2.x), bfhi(w2.x), bflo(w2.y), bfhi(w2.y)}; s2[u] = (y[0] * y[0] + y[1] * y[1]) + (y[2] * y[2] + y[3] * y[3]); }
        if (r0 < 24) PK_LOAD(r0 + 8)
#pragma unroll
        for (int o = 1; o < 64; o <<= 1) {
#pragma unroll
            for (int u = 0; u < 8; ++u) s2[u] += __shfl_xor(s2[u], o); }
#pragma unroll
        for (int u = 0; u < 8; ++u) { const int t = tb + 32 * F.wave + r0 + u; const float r2 = 1.0f / sqrtf(s2[u] * (1.f / 256.f) + RMS_EPS);
            const v2u w2 = wk[u]; const float y[4] = {bflo(w2.x), bfhi(w2.x), bflo(w2.y), bfhi(w2.y)};
            v2u o2; o2.x = pk2(y[0] * r2 * gk.x, y[1] * r2 * gk.y); o2.y = pk2(y[2] * r2 * gk.z, y[3] * r2 * gk.w);
            *(v2u*)((bf16*)(F.ws + WS_CKVN) + (size_t)t * 256 + lane * 4) = o2;
            if (rope) {
                const float x1 = rr[u][0], x2 = rr[u][1], c = rr[u][2], sn = rr[u][3];
                const bf16 o1 = (bf16)f2bf(x1 * c - x2 * sn), ob = (bf16)f2bf(x1 * sn + x2 * c); bf16* KM = (bf16*)(F.ws + WS_KM);
#pragma unroll
                for (int hh = 0; hh < 2; ++hh) { bf16* kp = KM + (size_t)t * 768 + (2 * hq + hh) * 96 + 64; kp[i16] = o1; kp[16 + i16] = ob; } } } }
#undef PK_LOAD
}
template <class A> __device__ __forceinline__ void p2_cmp_rows(Frame& F, const A& args, int l, int which, int s, int pm) {
    const int lane = F.lane; const bf16* ACT = (const bf16*)(F.ws + WS_ACT); const float* pe0 = args.in[which ? 11 : 8] + (size_t)l * 2048;
    const int li = s * 8 + (lane >> 3), d = (lane & 7) * 8; const float* pe = pe0 + li * 64 + d; const f32x4 p0 = *(const f32x4*)pe, p1 = *(const f32x4*)(pe + 4);
    bf16* AB = (bf16*)(F.ws + (which ? WS_ABV : WS_ABK)) + (size_t)s * 1024 * 512;
    v4u nx[8];
#define PC_LOAD(r0) { _Pragma("unroll") for (int u = 0; u < 8; ++u) { int R = 256 * pm + 32 * F.wave + (r0) + u; R = R < 1016 ? R : 1015; const int g = R & 1, bc = R >> 1, b = bc / 127, c = bc - b * 127; \
            nx[u] = *(const v4u*)(ACT + (size_t)(b * SEQ + 16 * c + li) * ACT_LD + (which ? C_NVC : C_NKC) + g * 64 + d); } }
    PC_LOAD(0)
#pragma nounroll
    for (int r0 = 0; r0 < 32; r0 += 8) { v4u w[8];
#pragma unroll
        for (int u = 0; u < 8; ++u) w[u] = nx[u];
        if (r0 < 24) PC_LOAD(r0 + 8)
#pragma unroll
        for (int u = 0; u < 8; ++u) { const int R = 256 * pm + 32 * F.wave + r0 + u; if (R >= 1016) continue;
            v4u o; o.x = pk2(bflo(w[u].x) + p0.x, bfhi(w[u].x) + p0.y); o.y = pk2(bflo(w[u].y) + p0.z, bfhi(w[u].y) + p0.w); o.z = pk2(bflo(w[u].z) + p1.x, bfhi(w[u].z) + p1.y); o.w = pk2(bflo(w[u].w) + p1.z, bfhi(w[u].w) + p1.w);
            *(v4u*)(AB + (size_t)R * 512 + (li & 7) * 64 + d) = o; } }
}
constexpr int AT_K = 0, AT_V = 13312, AT_FK = 22016, AT_BUF = 22528  , AT_CK = 45056, AT_CV = 63488, AT_IMP = 80384, AT_SC = 114176, AT_SELM = 122624, AT_FLAG = 123392;
constexpr int VSTR = 136;
#define MFMA32(a, b, c) __builtin_amdgcn_mfma_f32_32x32x16_bf16((a), (b), (c), 0, 0, 0)
__device__ __forceinline__ unsigned cvtpk(float lo, float hi) { typedef __bf16 bf2 __attribute__((ext_vector_type(2))); f32x2 v = {lo, hi}; bf2 b = __builtin_convertvector(v, bf2); return __builtin_bit_cast(unsigned, b); }
__device__ __forceinline__ float ex2(float x) { return __builtin_amdgcn_exp2f(x); }

template <int NK> struct KRegs { v4u r[(NK * 2 * 64 + 511) / 512]; };
template <int NK> __device__ __forceinline__ void k_gload(KRegs<NK>& R, const bf16* Kg, int pitch, int tid) {
    constexpr int CH = NK * 2, N = CH * 64;
#pragma unroll
    for (int i = 0; i < (N + 511) / 512; ++i) { const int id = tid + i * 512; if (id < N) { const int row = id / CH, ch = id % CH; R.r[i] = *(const v4u*)(Kg + (size_t)row * pitch + ch * 8); } }
}
template <int NK, int KSTR> __device__ __forceinline__ void k_lwrite(const KRegs<NK>& R, LAS unsigned char* Kt, int tid) {
    constexpr int CH = NK * 2, N = CH * 64;
#pragma unroll
    for (int i = 0; i < (N + 511) / 512; ++i) { const int id = tid + i * 512; if (id < N) { const int row = id / CH, ch = id % CH; *(LAS v4u*)(Kt + row * KSTR + ch * 16) = R.r[i]; } }
}
__device__ __forceinline__ v4u v_gload(const bf16* VTg  , int tid) { return *(const v4u*)(VTg + (size_t)(tid >> 3) * VT_LD + (tid & 7) * 8); }
__device__ __forceinline__ void v_lwrite(v4u v, LAS unsigned char* Vt, int tid) { LAS unsigned char* p = Vt + (tid >> 3) * VSTR + (tid & 7) * 16; *(LAS v2u*)p = (v2u){v.x, v.y}; *(LAS v2u*)(p + 8) = (v2u){v.z, v.w}; }

template <int NK, int KSTR>
__device__ __forceinline__ void qk_tile(f32x16& s0, f32x16& s1, const LAS unsigned char* Kt, const bf16x8 (&qf)[NK], int r32, int hi) {
    f32x16 z = {}; s0 = z; s1 = z;
#pragma unroll
    for (int kk = 0; kk < NK; ++kk) {
        const bf16x8 a0 = *(const LAS bf16x8*)(Kt + r32 * KSTR + kk * 32 + hi * 16);
        const bf16x8 a1 = *(const LAS bf16x8*)(Kt + (r32 + 32) * KSTR + kk * 32 + hi * 16);
        s0 = MFMA32(a0, qf[kk], s0); s1 = MFMA32(a1, qf[kk], s1);
    }
}
template <int VS>
__device__ __forceinline__ void pv_tile(f32x16& o0, f32x16& o1, const LAS unsigned char* Vt, const f32x16& p0, const f32x16& p1, int r32, int hi, int koff) {
#pragma unroll
    for (int ks = 0; ks < 4; ++ks) {
        v4u pw;
        if (ks < 2) { const int b8 = 8 * (ks & 1); pw.x = cvtpk(p0[b8 + 0], p0[b8 + 1]); pw.y = cvtpk(p0[b8 + 2], p0[b8 + 3]); pw.z = cvtpk(p0[b8 + 4], p0[b8 + 5]); pw.w = cvtpk(p0[b8 + 6], p0[b8 + 7]); }
        else        { const int b8 = 8 * (ks & 1); pw.x = cvtpk(p1[b8 + 0], p1[b8 + 1]); pw.y = cvtpk(p1[b8 + 2], p1[b8 + 3]); pw.z = cvtpk(p1[b8 + 4], p1[b8 + 5]); pw.w = cvtpk(p1[b8 + 6], p1[b8 + 7]); }
        const bf16x8 pb = __builtin_bit_cast(bf16x8, pw);
        const LAS unsigned char* va = Vt + r32 * VS + koff + ks * 32 + hi * 8;
        const v2u x0 = *(const LAS v2u*)va, x1 = *(const LAS v2u*)(va + 16);
        const v2u y0 = *(const LAS v2u*)(va + 32 * VS), y1 = *(const LAS v2u*)(va + 32 * VS + 16);
        const bf16x8 a0 = __builtin_bit_cast(bf16x8, ((v4u){x0.x, x0.y, x1.x, x1.y}));
        const bf16x8 a1 = __builtin_bit_cast(bf16x8, ((v4u){y0.x, y0.y, y1.x, y1.y}));
        o0 = MFMA32(a0, pb, o0); o1 = MFMA32(a1, pb, o1);
    }
}
struct Sm { float m, l; f32x16 o0, o1; };
__device__ __forceinline__ void sm_init(Sm& s) { s.m = -INFINITY; s.l = 0.f; f32x16 z = {}; s.o0 = z; s.o1 = z; }
__device__ __forceinline__ void sm_update(Sm& st, f32x16& s0, f32x16& s1, float c1) {
    float mx = fmaxf(s0[0], s1[0]);
#pragma unroll
    for (int r = 1; r < 16; ++r) mx = fmaxf(mx, fmaxf(s0[r], s1[r]));
    mx = fmaxf(mx, __shfl_xor(mx, 32));
    const float mn = fmaxf(st.m, mx); const float nmu = (mn == -INFINITY) ? 0.f : -mn * c1;
    if (!__all(mn == st.m)) { const float alpha = ex2(st.m == -INFINITY ? -INFINITY : fmaf(st.m, c1, nmu)); st.l *= alpha; st.o0 *= alpha; st.o1 *= alpha; st.m = mn; }
    float sum = 0.f;
#pragma unroll
    for (int r = 0; r < 16; ++r) { s0[r] = ex2(fmaf(s0[r], c1, nmu)); s1[r] = ex2(fmaf(s1[r], c1, nmu)); sum += s0[r] + s1[r]; }
    st.l += sum;
}
__device__ __forceinline__ float sm_inv_l(const Sm& st) { const float lt = st.l + __shfl_xor(st.l, 32); return lt > 0.f ? 1.0f / lt : 0.f; }
__device__ __forceinline__ void store_o(bf16* orow, const f32x16& o0, const f32x16& o1, int hi) {
#pragma unroll
    for (int gq = 0; gq < 4; ++gq) {
        v2u w; w.x = cvtpk(o0[4 * gq], o0[4 * gq + 1]); w.y = cvtpk(o0[4 * gq + 2], o0[4 * gq + 3]); *(v2u*)(orow + 4 * hi + 8 * gq) = w;
        w.x = cvtpk(o1[4 * gq], o1[4 * gq + 1]); w.y = cvtpk(o1[4 * gq + 2], o1[4 * gq + 3]); *(v2u*)(orow + 32 + 4 * hi + 8 * gq) = w; }
}
struct MaskCausal { int qpos, qw0, hi; float c1;
    __device__ __forceinline__ bool active(int t) const { return 64 * t <= qw0 + 31; }
    __device__ __forceinline__ void apply(int t, f32x16& s0, f32x16& s1, const LAS unsigned char*) const {
        if (64 * t + 63 > qw0) {
#pragma unroll
            for (int r = 0; r < 16; ++r) { const int k0 = 64 * t + 8 * (r >> 2) + 4 * hi + (r & 3); if (k0 > qpos) s0[r] = -INFINITY; if (k0 + 32 > qpos) s1[r] = -INFINITY; } } }
};
struct MaskFox { int qpos, qw0, hi; float c1, fq;
    __device__ __forceinline__ bool active(int t) const { return 64 * t <= qw0 + 31; }
    __device__ __forceinline__ void apply(int t, f32x16& s0, f32x16& s1, const LAS unsigned char* lds) const {
        const bool nm = (64 * t + 63 > qw0); const LAS float* fk = (const LAS float*)(lds + AT_FK);
#pragma unroll
        for (int gq = 0; gq < 4; ++gq) { const f32x4 f0 = *(const LAS f32x4*)(fk + 8 * gq + 4 * hi), f1 = *(const LAS f32x4*)(fk + 32 + 8 * gq + 4 * hi);
#pragma unroll
            for (int i = 0; i < 4; ++i) { const int r = 4 * gq + i; s0[r] += fq - f0[i]; s1[r] += fq - f1[i]; } }
        if (nm) {
#pragma unroll
            for (int r = 0; r < 16; ++r) { const int k0 = 64 * t + 8 * (r >> 2) + 4 * hi + (r & 3); if (k0 > qpos) s0[r] = -INFINITY; if (k0 + 32 > qpos) s1[r] = -INFINITY; } } }
};
struct MaskNsa { int qpos, qw0, hi; float c1; unsigned sel; int qt, mode;
    __device__ __forceinline__ bool active(int t) const { return mode == 0 || (64 * t <= qw0 + 31 && 64 * t + 63 >= qw0 - 511); }
    __device__ __forceinline__ void apply(int t, f32x16& s0, f32x16& s1, const LAS unsigned char*) const {
        const bool off = (mode == 0) && !((sel >> t) & 1u); const int wlim = mode ? 512 : (1 << 30);
        const bool nm = (64 * t + 63 > qw0) || (mode && (64 * t < qw0 + 31 - 511));
        if (off) {
#pragma unroll
            for (int r = 0; r < 16; ++r) { s0[r] = -INFINITY; s1[r] = -INFINITY; } }
        if (nm) {
#pragma unroll
            for (int r = 0; r < 16; ++r) { const int k0 = 64 * t + 8 * (r >> 2) + 4 * hi + (r & 3);
                if (k0 > qpos || qpos - k0 >= wlim) s0[r] = -INFINITY; if (k0 + 32 > qpos || qpos - (k0 + 32) >= wlim) s1[r] = -INFINITY; } } }
};
template <int NK, int KSTR, bool FOX, class MaskF>
__device__ __forceinline__ void attn_loop(Frame& F, const bf16* Kg, int kpitch, const bf16* VTg, const float* Fg, unsigned tilemask, const bf16x8 (&qf)[NK], Sm& st, const MaskF& mf) {
    const int tid = F.tid, r32 = F.lane & 31, hi = F.lane >> 5; LAS unsigned char* lds = F.lds;
    unsigned rem = tilemask; if (!rem) return;
    int t = __ffs(rem) - 1; rem &= rem - 1;
    KRegs<NK> kr; v4u vr; float fr = 0.f;
    k_gload<NK>(kr, Kg + (size_t)(64 * t) * kpitch, kpitch, tid); vr = v_gload(VTg + 64 * t, tid); if (FOX && tid < 64) fr = 8.0f * Fg[64 * t + tid];
    __syncthreads();
    k_lwrite<NK, KSTR>(kr, lds + AT_K, tid); v_lwrite(vr, lds + AT_V, tid); if (FOX && tid < 64) ((LAS float*)(lds + AT_FK))[tid] = fr;
    int tc = t, cb = 0; bool more = rem != 0u;
    if (more) { t = __ffs(rem) - 1; rem &= rem - 1; k_gload<NK>(kr, Kg + (size_t)(64 * t) * kpitch, kpitch, tid); vr = v_gload(VTg + 64 * t, tid); if (FOX && tid < 64) fr = 8.0f * Fg[64 * t + tid]; }
    for (;;) {
        asm volatile("s_waitcnt lgkmcnt(0)" ::: "memory"); __builtin_amdgcn_s_barrier(); asm volatile("" ::: "memory");
        LAS unsigned char* cur = lds + cb * AT_BUF; LAS unsigned char* nxt = lds + (cb ^ 1) * AT_BUF;
        const int tn = t; const bool more2 = more;
        if (more) { k_lwrite<NK, KSTR>(kr, nxt + AT_K, tid); v_lwrite(vr, nxt + AT_V, tid); if (FOX && tid < 64) ((LAS float*)(nxt + AT_FK))[tid] = fr;
            more = rem != 0u;
            if (more) { t = __ffs(rem) - 1; rem &= rem - 1; k_gload<NK>(kr, Kg + (size_t)(64 * t) * kpitch, kpitch, tid); vr = v_gload(VTg + 64 * t, tid); if (FOX && tid < 64) fr = 8.0f * Fg[64 * t + tid]; } }
        if (mf.active(tc)) { f32x16 s0, s1; qk_tile<NK, KSTR>(s0, s1, cur + AT_K, qf, r32, hi);
#if XDUP == 1
            { f32x16 d0, d1; asm volatile("" : "+v"(s0), "+v"(s1)); qk_tile<NK, KSTR>(d0, d1, cur + AT_K, qf, r32, hi); asm volatile("" :: "v"(d0), "v"(d1)); }
#endif
            mf.apply(tc, s0, s1, cur);
#if XDUP == 2
            { f32x16 d0 = s0, d1 = s1; asm volatile("" : "+v"(d0), "+v"(d1)); float mx = fmaxf(d0[0], d1[0]);
              _Pragma("unroll") for (int r = 1; r < 16; ++r) mx = fmaxf(mx, fmaxf(d0[r], d1[r])); mx = fmaxf(mx, __shfl_xor(mx, 32)); const float nmu2 = (mx == -INFINITY) ? 0.f : -mx * mf.c1; float sm2 = 0.f;
              _Pragma("unroll") for (int r = 0; r < 16; ++r) { d0[r] = ex2(fmaf(d0[r], mf.c1, nmu2)); d1[r] = ex2(fmaf(d1[r], mf.c1, nmu2)); sm2 += d0[r] + d1[r]; } asm volatile("" :: "v"(sm2)); }
#endif
            sm_update(st, s0, s1, mf.c1);
#if XDUP == 3
            { f32x16 e0 = st.o0, e1 = st.o1; asm volatile("" : "+v"(e0), "+v"(e1)); pv_tile<VSTR>(e0, e1, cur + AT_V, s0, s1, r32, hi, 0); asm volatile("" :: "v"(e0), "v"(e1)); }
#endif
            pv_tile<VSTR>(st.o0, st.o1, cur + AT_V, s0, s1, r32, hi, 0); }
        if (!more2) break;
        tc = tn; cb ^= 1;
    }
}
__device__ __forceinline__ unsigned low_mask(int n) { return n >= 32 ? 0xffffffffu : ((1u << n) - 1u); }

__device__ __forceinline__ void fox_unit(Frame& F, int l, int b, int h, int qt) {
    const int r32 = F.lane & 31, hi = F.lane >> 5; const int qw0 = qt * 256 + 32 * F.wave, qpos = qw0 + r32; const size_t tq = (size_t)b * SEQ + qpos;
    const bf16* ACT = (const bf16*)(F.ws + WS_ACT); const float* Fg = (const float*)(F.ws + WS_FCUM) + (size_t)(b * 8 + h) * SEQ;
    bf16x8 qf[4];
#pragma unroll
    for (int kk = 0; kk < 4; ++kk) qf[kk] = *(const bf16x8*)(ACT + tq * ACT_LD + C_FQ + h * 64 + kk * 16 + hi * 8);
    Sm st; sm_init(st); MaskFox mf{qpos, qw0, hi, 0.125f * LOG2E, 8.0f * Fg[qpos]};
    int tlo = 4 * qt + 3; { const unsigned* nb = (const unsigned*)(F.ctl + CW_FOXN) + l * 64 + (b * 8 + h) * 2; const float B = 0.125f * 1.001f * sqrtf(__uint_as_float(nb[0])) * sqrtf(__uint_as_float(nb[1]));
      const float thr = -110.0f - 2.0f * B - Fg[qt * 256]; while (tlo > 0 && !(-Fg[64 * (tlo - 1) + 63] < thr)) --tlo; }
    attn_loop<4, 144, true>(F, ACT + (size_t)b * SEQ * ACT_LD + C_FK + h * 64, ACT_LD, (const bf16*)(F.ws + WS_VT) + (size_t)(R_FV + h * 64) * VT_LD + (size_t)b * SEQ, Fg, low_mask(4 * qt + 4) & ~low_mask(tlo), qf, st, mf);
    float il = sm_inv_l(st);
#if ABL == 1
    il = 0.f;
#endif
    st.o0 *= il; st.o1 *= il;
    store_o((bf16*)(F.ws + WS_BR) + tq * 512 + h * 64, st.o0, st.o1, hi);
}
__device__ __forceinline__ void mla_unit(Frame& F, int b, int h, int qt) {
    const int r32 = F.lane & 31, hi = F.lane >> 5; const int qw0 = qt * 256 + 32 * F.wave, qpos = qw0 + r32; const size_t tq = (size_t)b * SEQ + qpos;
    const bf16* QM = (const bf16*)(F.ws + WS_QM); const bf16* KM = (const bf16*)(F.ws + WS_KM);
    bf16x8 qf[6];
#pragma unroll
    for (int kk = 0; kk < 6; ++kk) qf[kk] = *(const bf16x8*)(QM + tq * 768 + h * 96 + kk * 16 + hi * 8);
    { const float* R32 = (const float*)(F.ws + WS_R32) + ((size_t)qpos * 16 + 8 * hi) * 2;
      v4u a = __builtin_bit_cast(v4u, qf[4]), bq = __builtin_bit_cast(v4u, qf[5]); unsigned ao[4], bo[4];
      const unsigned aw[4] = {a.x, a.y, a.z, a.w}, bw[4] = {bq.x, bq.y, bq.z, bq.w};
#pragma unroll
      for (int p = 0; p < 4; ++p) { const f32x4 cs = *(const f32x4*)(R32 + 4 * p);
          const float x1a = bflo(aw[p]), x1b = bfhi(aw[p]), x2a = bflo(bw[p]), x2b = bfhi(bw[p]);
          ao[p] = cvtpk(x1a * cs[0] - x2a * cs[1], x1b * cs[2] - x2b * cs[3]); bo[p] = cvtpk(x1a * cs[1] + x2a * cs[0], x1b * cs[3] + x2b * cs[2]); }
      qf[4] = __builtin_bit_cast(bf16x8, ((v4u){ao[0], ao[1], ao[2], ao[3]})); qf[5] = __builtin_bit_cast(bf16x8, ((v4u){bo[0], bo[1], bo[2], bo[3]})); }
    Sm st; sm_init(st); MaskCausal mf{qpos, qw0, hi, 0.10206207261596575f * LOG2E};
    attn_loop<6, 208, false>(F, KM + (size_t)b * SEQ * 768 + h * 96, 768, (const bf16*)(F.ws + WS_VT) + (size_t)(R_MV + h * 64) * VT_LD + (size_t)b * SEQ, nullptr, low_mask(4 * qt + 4), qf, st, mf);
    float il = sm_inv_l(st);
#if ABL == 2
    il = 0.f;
#endif
    st.o0 *= il; st.o1 *= il;
    store_o((bf16*)(F.ws + WS_BR) + ((size_t)NTOK + tq) * 512 + h * 64, st.o0, st.o1, hi);
}
__device__ __forceinline__ void sb_unit(Frame& F, int b, int h, int qt) {
    const int tid = F.tid, r32 = F.lane & 31, hi = F.lane >> 5; LAS unsigned char* lds = F.lds;
    const int qw0 = qt * 256 + 32 * F.wave, qpos = qw0 + r32; const size_t tq = (size_t)b * SEQ + qpos;
    const bf16* ACT = (const bf16*)(F.ws + WS_ACT);
    bf16x8 qf[4];
#pragma unroll
    for (int kk = 0; kk < 4; ++kk) qf[kk] = *(const bf16x8*)(ACT + tq * ACT_LD + C_SQ + h * 64 + kk * 16 + hi * 8);
    const bf16* Kg = ACT + (size_t)b * SEQ * ACT_LD + C_SK + h * 64; const bf16* VTg = (const bf16*)(F.ws + WS_VT) + (size_t)(R_SV + h * 64) * VT_LD + (size_t)b * SEQ;
    f32x16 o0 = {}, o1 = {}; float R = 0.f;
    int t = 4 * qt + 3; KRegs<4> kr; v4u vr;
    k_gload<4>(kr, Kg + (size_t)(64 * t) * ACT_LD, ACT_LD, tid); vr = v_gload(VTg + 64 * t, tid);
    volatile LAS unsigned* flag = (volatile LAS unsigned*)(lds + AT_FLAG);
    __syncthreads();
    k_lwrite<4, 144>(kr, lds + AT_K, tid); v_lwrite(vr, lds + AT_V, tid);
    int tc = t, cb = 0, it = 0; bool more = t > 0;
    if (more) { --t; k_gload<4>(kr, Kg + (size_t)(64 * t) * ACT_LD, ACT_LD, tid); vr = v_gload(VTg + 64 * t, tid); }
    for (;; ++it) {
        const bool wok = __all(R < -159.f); if (F.lane == 0) flag[(it & 1) * 8 + F.wave] = wok ? 1u : 0u;
        __syncthreads();
        unsigned allok = 1u;
#pragma unroll
        for (int w = 0; w < 8; ++w) allok &= flag[(it & 1) * 8 + w];
        if (allok) break;
        LAS unsigned char* cur = lds + cb * AT_BUF; LAS unsigned char* nxt = lds + (cb ^ 1) * AT_BUF;
        const int tn = t; const bool more2 = more;
        if (more) { k_lwrite<4, 144>(kr, nxt + AT_K, tid); v_lwrite(vr, nxt + AT_V, tid); more = t > 0;
            if (more) { --t; k_gload<4>(kr, Kg + (size_t)(64 * t) * ACT_LD, ACT_LD, tid); vr = v_gload(VTg + 64 * t, tid); } }
        if (64 * tc < qw0 + 31) {
            f32x16 s0, s1; qk_tile<4, 144>(s0, s1, cur + AT_K, qf, r32, hi);
            f32x16 lb0, lb1;
            const bool nm = (64 * tc + 63 >= qw0);
#pragma unroll
            for (int r = 0; r < 16; ++r) {
                const float z0 = s0[r] * (0.125f * LOG2E), z1 = s1[r] * (0.125f * LOG2E);
                const float l0 = fminf(z0, 0.f) - __builtin_amdgcn_logf(1.0f + ex2(-fabsf(z0))), l1 = fminf(z1, 0.f) - __builtin_amdgcn_logf(1.0f + ex2(-fabsf(z1)));
                lb0[r] = l0; lb1[r] = l1; s0[r] = l0 - z0; s1[r] = l1 - z1; }
            if (nm) {
#pragma unroll
                for (int r = 0; r < 16; ++r) { const int k0 = 64 * tc + 8 * (r >> 2) + 4 * hi + (r & 3); if (!(k0 < qpos)) s0[r] = 0.f; if (!(k0 + 32 < qpos)) s1[r] = 0.f; } }
            float mine[8], part[8];
#pragma unroll
            for (int gq = 0; gq < 4; ++gq) { mine[gq] = (s0[4 * gq] + s0[4 * gq + 1]) + (s0[4 * gq + 2] + s0[4 * gq + 3]); mine[4 + gq] = (s1[4 * gq] + s1[4 * gq + 1]) + (s1[4 * gq + 2] + s1[4 * gq + 3]); }
#pragma unroll
            for (int k = 0; k < 8; ++k) part[k] = __shfl_xor(mine[k], 32);
            float suf[17]; suf[16] = 0.f;
            float e[16];
#pragma unroll
            for (int k = 0; k < 8; ++k) { e[2 * k] = hi ? part[k] : mine[k]; e[2 * k + 1] = hi ? mine[k] : part[k]; }
            suf[15] = 0.f;
#pragma unroll
            for (int G = 14; G >= 0; --G) suf[G] = suf[G + 1] + e[G + 1];
            const float total = suf[0] + e[0];
#pragma unroll
            for (int k = 0; k < 8; ++k) { const float T = R + (hi ? suf[2 * k + 1] : suf[2 * k]);
                if (k < 4) { const int q4 = 4 * k; const float t3 = T, t2 = t3 + s0[q4 + 3], t1 = t2 + s0[q4 + 2], t0 = t1 + s0[q4 + 1];
                    s0[q4] = ex2(lb0[q4] + t0); s0[q4 + 1] = ex2(lb0[q4 + 1] + t1); s0[q4 + 2] = ex2(lb0[q4 + 2] + t2); s0[q4 + 3] = ex2(lb0[q4 + 3] + t3); }
                else { const int q4 = 4 * (k - 4); const float t3 = T, t2 = t3 + s1[q4 + 3], t1 = t2 + s1[q4 + 2], t0 = t1 + s1[q4 + 1];
                    s1[q4] = ex2(lb1[q4] + t0); s1[q4 + 1] = ex2(lb1[q4 + 1] + t1); s1[q4 + 2] = ex2(lb1[q4 + 2] + t2); s1[q4 + 3] = ex2(lb1[q4 + 3] + t3); } }
            if (nm) {
#pragma unroll
                for (int r = 0; r < 16; ++r) { const int k0 = 64 * tc + 8 * (r >> 2) + 4 * hi + (r & 3); if (!(k0 < qpos)) s0[r] = 0.f; if (!(k0 + 32 < qpos)) s1[r] = 0.f; } }
            R += total;
            pv_tile<VSTR>(o0, o1, cur + AT_V, s0, s1, r32, hi, 0);
        }
        if (!more2) break;
        tc = tn; cb ^= 1;
    }
    __syncthreads();
#if ABL == 6
    o0 *= 0.f; o1 *= 0.f;
#endif
    store_o((bf16*)(F.ws + WS_BR) + ((size_t)3 * NTOK + tq) * 512 + h * 64, o0, o1, hi);
}
__device__ __forceinline__ void nsa_unit(Frame& F, int b, int g, int qt) {
    const int tid = F.tid, lane = F.lane, r32 = lane & 31, hi = lane >> 5, wave = F.wave; LAS unsigned char* lds = F.lds;
    const int hh = g * 4 + (wave >> 1); const int q0 = 64 * qt, qw0 = q0 + 32 * (wave & 1), qpos = qw0 + r32; const size_t tq = (size_t)b * SEQ + qpos;
    const bf16* ACT = (const bf16*)(F.ws + WS_ACT); const float* MISC = (const float*)(F.ws + WS_MISC);
    const float c1 = 0.125f * LOG2E;
    bf16x8 qf[4];
#pragma unroll
    for (int kk = 0; kk < 4; ++kk) qf[kk] = *(const bf16x8*)(ACT + tq * ACT_LD + C_NQ + hh * 64 + kk * 16 + hi * 8);
    float g0 = sigmoidf_(MISC[tq * 64 + 40 + hh * 3]), g1 = sigmoidf_(MISC[tq * 64 + 40 + hh * 3 + 1]), g2 = sigmoidf_(MISC[tq * 64 + 40 + hh * 3 + 2]);
#if ABL == 3
    g0 = 0.f;
#elif ABL == 4
    g1 = 0.f;
#elif ABL == 5
    g2 = 0.f;
#endif
    __syncthreads();
    { const bf16* KC = (const bf16*)(F.ws + WS_KC) + (size_t)(b * 2 + g) * 128 * 64; const bf16* VC = (const bf16*)(F.ws + WS_VCT) + (size_t)(b * 2 + g) * 64 * 128;
#pragma unroll
      for (int i = 0; i < 2; ++i) { const int id = tid + i * 512; const v4u kv = *(const v4u*)(KC + (size_t)id * 8); *(LAS v4u*)(lds + AT_CK + (id >> 3) * 144 + (id & 7) * 16) = kv;
          const v4u vv = *(const v4u*)(VC + (size_t)id * 8); LAS unsigned char* p = lds + AT_CV + (id >> 4) * 264 + (id & 15) * 16; *(LAS v2u*)p = (v2u){vv.x, vv.y}; *(LAS v2u*)(p + 8) = (v2u){vv.z, vv.w}; } }
    __syncthreads();
    f32x16 acc0 = {}, acc1 = {};
    {
        f32x16 s[4];
        qk_tile<4, 144>(s[0], s[1], lds + AT_CK, qf, r32, hi); qk_tile<4, 144>(s[2], s[3], lds + AT_CK + 64 * 144, qf, r32, hi);
        const int ncv = qpos >= 31 ? ((qpos - 31) >> 4) + 1 : 0;
        float mx = -INFINITY;
#pragma unroll
        for (int a = 0; a < 4; ++a)
#pragma unroll
            for (int r = 0; r < 16; ++r) { const int c = 32 * a + 8 * (r >> 2) + 4 * hi + (r & 3); const float v = (c < ncv) ? s[a][r] * c1 : -INFINITY; s[a][r] = v; mx = fmaxf(mx, v); }
        mx = fmaxf(mx, __shfl_xor(mx, 32)); const float mu = (mx == -INFINITY) ? 0.f : mx; float sum = 0.f;
#pragma unroll
        for (int a = 0; a < 4; ++a)
#pragma unroll
            for (int r = 0; r < 16; ++r) { s[a][r] = ex2(s[a][r] - mu); sum += s[a][r]; }
        sum += __shfl_xor(sum, 32); const float inv = sum > 0.f ? 1.0f / sum : 0.f;
#pragma unroll
        for (int a = 0; a < 4; ++a) s[a] *= inv;
        f32x16 oc0 = {}, oc1 = {};
        pv_tile<264>(oc0, oc1, lds + AT_CV, s[0], s[1], r32, hi, 0); pv_tile<264>(oc0, oc1, lds + AT_CV, s[2], s[3], r32, hi, 128);
        acc0 = oc0 * g0; acc1 = oc1 * g0;
        LAS float* imp = (LAS float*)(lds + AT_IMP) + (wave * 32 + r32) * 33;
        float prevc = 0.f;
#pragma unroll
        for (int a = 0; a < 4; ++a)
#pragma unroll
            for (int gq = 0; gq < 4; ++gq) { const float inner = (s[a][4 * gq] + s[a][4 * gq + 1]) + (s[a][4 * gq + 2] + 0.5f * s[a][4 * gq + 3]); const float carry = 0.5f * s[a][4 * gq + 3];
                const float pc = __shfl_xor(carry, 32);
                imp[8 * a + 2 * gq + hi] = inner + (hi ? pc : prevc); prevc = pc; }
    }
    __syncthreads();
    {
        const int q = tid >> 3, j4 = (tid & 7) * 4; const int pos = q0 + q, cur = pos >> 6; const LAS float* impb = (const LAS float*)(lds + AT_IMP); LAS float* sc = (LAS float*)(lds + AT_SC);
#pragma unroll
        for (int jj = 0; jj < 4; ++jj) { const int j = j4 + jj; float v = 0.f;
#pragma unroll
            for (int hd = 0; hd < 4; ++hd) v += impb[((hd * 2 + (q >> 5)) * 32 + (q & 31)) * 33 + j];
            const bool valid = 64 * j <= pos; const bool forced = (j == 0) || (j == cur) || (j == cur - 1);
            sc[q * 33 + j] = valid ? v + (forced ? 1000.f : 0.f) : -1e30f; }
    }
    __syncthreads();
    {
        const LAS float* sc = (const LAS float*)(lds + AT_SC); LAS unsigned* selm = (LAS unsigned*)(lds + AT_SELM);
#pragma unroll
        for (int it = 0; it < 4; ++it) { const int q = 8 * wave + 2 * it + hi, j = r32; const float my = sc[q * 33 + j]; int rank = 0;
#pragma unroll
            for (int j2 = 0; j2 < 32; ++j2) { const float o = sc[q * 33 + j2]; rank += (o > my || (o == my && j2 < j)) ? 1 : 0; }
            const bool sel = rank < 16 && (64 * j <= q0 + q);
            const unsigned long long bal = __ballot(sel);
            if (lane == 0) selm[8 * wave + 2 * it] = (unsigned)bal; if (lane == 32) selm[8 * wave + 2 * it + 1] = (unsigned)(bal >> 32); }
    }
    __syncthreads();
    unsigned mysel, uni;
    { const LAS unsigned* selm = (const LAS unsigned*)(lds + AT_SELM); mysel = selm[32 * (wave & 1) + r32]; uni = selm[lane];
#pragma unroll
      for (int o = 1; o < 64; o <<= 1) uni |= __shfl_xor(uni, o); }
    const bf16* Kb = ACT + (size_t)b * SEQ * ACT_LD; const bf16* VTb = (const bf16*)(F.ws + WS_VT) + (size_t)b * SEQ;
    {
        const int tlo = (q0 - 511) > 0 ? (q0 - 511) >> 6 : 0;
#pragma nounroll
        for (int br = 0; br < 2; ++br) {
            Sm st; sm_init(st); MaskNsa mf{qpos, qw0, hi, c1, mysel, qt, br};
            const unsigned tiles = br ? (low_mask(qt + 1) & ~low_mask(tlo)) : (uni & low_mask(qt + 1));
            attn_loop<4, 144, false>(F, Kb + (br ? C_NKW : C_NKS) + g * 64, ACT_LD, VTb + (size_t)((br ? R_NVW : R_NVS) + g * 64) * VT_LD, nullptr, tiles, qf, st, mf);
            const float il = sm_inv_l(st) * (br ? g2 : g1); acc0 += st.o0 * il; acc1 += st.o1 * il;
        }
    }
    store_o((bf16*)(F.ws + WS_BR) + ((size_t)2 * NTOK + tq) * 512 + hh * 64, acc0, acc1, hi);
}
#define MFMA16(a, b, c) __builtin_amdgcn_mfma_f32_16x16x32_bf16((a), (b), (c), 0, 0, 0)
__device__ __forceinline__ float half_max(float v) {
#pragma unroll
    for (int o = 1; o < 32; o <<= 1) v = fmaxf(v, __shfl_xor(v, o));
    return v;
}
__device__ __forceinline__ float half_sum(float v) {
#pragma unroll
    for (int o = 1; o < 32; o <<= 1) v += __shfl_xor(v, o);
    return v;
}
template <int CTRL> __device__ __forceinline__ float dppf(float v) { return __int_as_float(__builtin_amdgcn_update_dpp(0, __float_as_int(v), CTRL, 0xF, 0xF, true)); }
template <int N> __device__ __forceinline__ void half_max_n(float (&m)[N]) {
    if constexpr (N == 16) {
        asm volatile("s_nop 1\n\tv_max_f32_dpp %0, %0, %0 quad_perm:[1,0,3,2] row_mask:0xf bank_mask:0xf\n\tv_max_f32_dpp %1, %1, %1 quad_perm:[1,0,3,2] row_mask:0xf bank_mask:0xf\n\tv_max_f32_dpp %2, %2, %2 quad_perm:[1,0,3,2] row_mask:0xf bank_mask:0xf\n\tv_max_f32_dpp %3, %3, %3 quad_perm:[1,0,3,2] row_mask:0xf bank_mask:0xf\n\tv_max_f32_dpp %4, %4, %4 quad_perm:[1,0,3,2] row_mask:0xf bank_mask:0xf\n\tv_max_f32_dpp %5, %5, %5 quad_perm:[1,0,3,2] row_mask:0xf bank_mask:0xf\n\tv_max_f32_dpp %6, %6, %6 quad_perm:[1,0,3,2] row_mask:0xf bank_mask:0xf\n\tv_max_f32_dpp %7, %7, %7 quad_perm:[1,0,3,2] row_mask:0xf bank_mask:0xf\n\tv_max_f32_dpp %8, %8, %8 quad_perm:[1,0,3,2] row_mask:0xf bank_mask:0xf\n\tv_max_f32_dpp %9, %9, %9 quad_perm:[1,0,3,2] row_mask:0xf bank_mask:0xf\n\tv_max_f32_dpp %10, %10, %10 quad_perm:[1,0,3,2] row_mask:0xf bank_mask:0xf\n\tv_max_f32_dpp %11, %11, %11 quad_perm:[1,0,3,2] row_mask:0xf bank_mask:0xf\n\tv_max_f32_dpp %12, %12, %12 quad_perm:[1,0,3,2] row_mask:0xf bank_mask:0xf\n\tv_max_f32_dpp %13, %13, %13 quad_perm:[1,0,3,2] row_mask:0xf bank_mask:0xf\n\tv_max_f32_dpp %14, %14, %14 quad_perm:[1,0,3,2] row_mask:0xf bank_mask:0xf\n\tv_max_f32_dpp %15, %15, %15 quad_perm:[1,0,3,2] row_mask:0xf bank_mask:0xf\n\t" : "+v"(m[0]), "+v"(m[1]), "+v"(m[2]), "+v"(m[3]), "+v"(m[4]), "+v"(m[5]), "+v"(m[6]), "+v"(m[7]), "+v"(m[8]), "+v"(m[9]), "+v"(m[10]), "+v"(m[11]), "+v"(m[12]), "+v"(m[13]), "+v"(m[14]), "+v"(m[15]));
        asm volatile("s_nop 1\n\tv_max_f32_dpp %0, %0, %0 quad_perm:[2,3,0,1] row_mask:0xf bank_mask:0xf\n\tv_max_f32_dpp %1, %1, %1 quad_perm:[2,3,0,1] row_mask:0xf bank_mask:0xf\n\tv_max_f32_dpp %2, %2, %2 quad_perm:[2,3,0,1] row_mask:0xf bank_mask:0xf\n\tv_max_f32_dpp %3, %3, %3 quad_perm:[2,3,0,1] row_mask:0xf bank_mask:0xf\n\tv_max_f32_dpp %4, %4, %4 quad_perm:[2,3,0,1] row_mask:0xf bank_mask:0xf\n\tv_max_f32_dpp %5, %5, %5 quad_perm:[2,3,0,1] row_mask:0xf bank_mask:0xf\n\tv_max_f32_dpp %6, %6, %6 quad_perm:[2,3,0,1] row_mask:0xf bank_mask:0xf\n\tv_max_f32_dpp %7, %7, %7 quad_perm:[2,3,0,1] row_mask:0xf bank_mask:0xf\n\tv_max_f32_dpp %8, %8, %8 quad_perm:[2,3,0,1] row_mask:0xf bank_mask:0xf\n\tv_max_f32_dpp %9, %9, %9 quad_perm:[2,3,0,1] row_mask:0xf bank_mask:0xf\n\tv_max_f32_dpp %10, %10, %10 quad_perm:[2,3,0,1] row_mask:0xf bank_mask:0xf\n\tv_max_f32_dpp %11, %11, %11 quad_perm:[2,3,0,1] row_mask:0xf bank_mask:0xf\n\tv_max_f32_dpp %12, %12, %12 quad_perm:[2,3,0,1] row_mask:0xf bank_mask:0xf\n\tv_max_f32_dpp %13, %13, %13 quad_perm:[2,3,0,1] row_mask:0xf bank_mask:0xf\n\tv_max_f32_dpp %14, %14, %14 quad_perm:[2,3,0,1] row_mask:0xf bank_mask:0xf\n\tv_max_f32_dpp %15, %15, %15 quad_perm:[2,3,0,1] row_mask:0xf bank_mask:0xf\n\t" : "+v"(m[0]), "+v"(m[1]), "+v"(m[2]), "+v"(m[3]), "+v"(m[4]), "+v"(m[5]), "+v"(m[6]), "+v"(m[7]), "+v"(m[8]), "+v"(m[9]), "+v"(m[10]), "+v"(m[11]), "+v"(m[12]), "+v"(m[13]), "+v"(m[14]), "+v"(m[15]));
        asm volatile("s_nop 1\n\tv_max_f32_dpp %0, %0, %0 row_half_mirror row_mask:0xf bank_mask:0xf\n\tv_max_f32_dpp %1, %1, %1 row_half_mirror row_mask:0xf bank_mask:0xf\n\tv_max_f32_dpp %2, %2, %2 row_half_mirror row_mask:0xf bank_mask:0xf\n\tv_max_f32_dpp %3, %3, %3 row_half_mirror row_mask:0xf bank_mask:0xf\n\tv_max_f32_dpp %4, %4, %4 row_half_mirror row_mask:0xf bank_mask:0xf\n\tv_max_f32_dpp %5, %5, %5 row_half_mirror row_mask:0xf bank_mask:0xf\n\tv_max_f32_dpp %6, %6, %6 row_half_mirror row_mask:0xf bank_mask:0xf\n\tv_max_f32_dpp %7, %7, %7 row_half_mirror row_mask:0xf bank_mask:0xf\n\tv_max_f32_dpp %8, %8, %8 row_half_mirror row_mask:0xf bank_mask:0xf\n\tv_max_f32_dpp %9, %9, %9 row_half_mirror row_mask:0xf bank_mask:0xf\n\tv_max_f32_dpp %10, %10, %10 row_half_mirror row_mask:0xf bank_mask:0xf\n\tv_max_f32_dpp %11, %11, %11 row_half_mirror row_mask:0xf bank_mask:0xf\n\tv_max_f32_dpp %12, %12, %12 row_half_mirror row_mask:0xf bank_mask:0xf\n\tv_max_f32_dpp %13, %13, %13 row_half_mirror row_mask:0xf bank_mask:0xf\n\tv_max_f32_dpp %14, %14, %14 row_half_mirror row_mask:0xf bank_mask:0xf\n\tv_max_f32_dpp %15, %15, %15 row_half_mirror row_mask:0xf bank_mask:0xf\n\t" : "+v"(m[0]), "+v"(m[1]), "+v"(m[2]), "+v"(m[3]), "+v"(m[4]), "+v"(m[5]), "+v"(m[6]), "+v"(m[7]), "+v"(m[8]), "+v"(m[9]), "+v"(m[10]), "+v"(m[11]), "+v"(m[12]), "+v"(m[13]), "+v"(m[14]), "+v"(m[15]));
        asm volatile("s_nop 1\n\tv_max_f32_dpp %0, %0, %0 row_mirror row_mask:0xf bank_mask:0xf\n\tv_max_f32_dpp %1, %1, %1 row_mirror row_mask:0xf bank_mask:0xf\n\tv_max_f32_dpp %2, %2, %2 row_mirror row_mask:0xf bank_mask:0xf\n\tv_max_f32_dpp %3, %3, %3 row_mirror row_mask:0xf bank_mask:0xf\n\tv_max_f32_dpp %4, %4, %4 row_mirror row_mask:0xf bank_mask:0xf\n\tv_max_f32_dpp %5, %5, %5 row_mirror row_mask:0xf bank_mask:0xf\n\tv_max_f32_dpp %6, %6, %6 row_mirror row_mask:0xf bank_mask:0xf\n\tv_max_f32_dpp %7, %7, %7 row_mirror row_mask:0xf bank_mask:0xf\n\tv_max_f32_dpp %8, %8, %8 row_mirror row_mask:0xf bank_mask:0xf\n\tv_max_f32_dpp %9, %9, %9 row_mirror row_mask:0xf bank_mask:0xf\n\tv_max_f32_dpp %10, %10, %10 row_mirror row_mask:0xf bank_mask:0xf\n\tv_max_f32_dpp %11, %11, %11 row_mirror row_mask:0xf bank_mask:0xf\n\tv_max_f32_dpp %12, %12, %12 row_mirror row_mask:0xf bank_mask:0xf\n\tv_max_f32_dpp %13, %13, %13 row_mirror row_mask:0xf bank_mask:0xf\n\tv_max_f32_dpp %14, %14, %14 row_mirror row_mask:0xf bank_mask:0xf\n\tv_max_f32_dpp %15, %15, %15 row_mirror row_mask:0xf bank_mask:0xf\n\t" : "+v"(m[0]), "+v"(m[1]), "+v"(m[2]), "+v"(m[3]), "+v"(m[4]), "+v"(m[5]), "+v"(m[6]), "+v"(m[7]), "+v"(m[8]), "+v"(m[9]), "+v"(m[10]), "+v"(m[11]), "+v"(m[12]), "+v"(m[13]), "+v"(m[14]), "+v"(m[15]));
    } else if constexpr (N == 8) {
        asm volatile("s_nop 1\n\tv_max_f32_dpp %0, %0, %0 quad_perm:[1,0,3,2] row_mask:0xf bank_mask:0xf\n\tv_max_f32_dpp %1, %1, %1 quad_perm:[1,0,3,2] row_mask:0xf bank_mask:0xf\n\tv_max_f32_dpp %2, %2, %2 quad_perm:[1,0,3,2] row_mask:0xf bank_mask:0xf\n\tv_max_f32_dpp %3, %3, %3 quad_perm:[1,0,3,2] row_mask:0xf bank_mask:0xf\n\tv_max_f32_dpp %4, %4, %4 quad_perm:[1,0,3,2] row_mask:0xf bank_mask:0xf\n\tv_max_f32_dpp %5, %5, %5 quad_perm:[1,0,3,2] row_mask:0xf bank_mask:0xf\n\tv_max_f32_dpp %6, %6, %6 quad_perm:[1,0,3,2] row_mask:0xf bank_mask:0xf\n\tv_max_f32_dpp %7, %7, %7 quad_perm:[1,0,3,2] row_mask:0xf bank_mask:0xf\n\t" : "+v"(m[0]), "+v"(m[1]), "+v"(m[2]), "+v"(m[3]), "+v"(m[4]), "+v"(m[5]), "+v"(m[6]), "+v"(m[7]));
        asm volatile("s_nop 1\n\tv_max_f32_dpp %0, %0, %0 quad_perm:[2,3,0,1] row_mask:0xf bank_mask:0xf\n\tv_max_f32_dpp %1, %1, %1 quad_perm:[2,3,0,1] row_mask:0xf bank_mask:0xf\n\tv_max_f32_dpp %2, %2, %2 quad_perm:[2,3,0,1] row_mask:0xf bank_mask:0xf\n\tv_max_f32_dpp %3, %3, %3 quad_perm:[2,3,0,1] row_mask:0xf bank_mask:0xf\n\tv_max_f32_dpp %4, %4, %4 quad_perm:[2,3,0,1] row_mask:0xf bank_mask:0xf\n\tv_max_f32_dpp %5, %5, %5 quad_perm:[2,3,0,1] row_mask:0xf bank_mask:0xf\n\tv_max_f32_dpp %6, %6, %6 quad_perm:[2,3,0,1] row_mask:0xf bank_mask:0xf\n\tv_max_f32_dpp %7, %7, %7 quad_perm:[2,3,0,1] row_mask:0xf bank_mask:0xf\n\t" : "+v"(m[0]), "+v"(m[1]), "+v"(m[2]), "+v"(m[3]), "+v"(m[4]), "+v"(m[5]), "+v"(m[6]), "+v"(m[7]));
        asm volatile("s_nop 1\n\tv_max_f32_dpp %0, %0, %0 row_half_mirror row_mask:0xf bank_mask:0xf\n\tv_max_f32_dpp %1, %1, %1 row_half_mirror row_mask:0xf bank_mask:0xf\n\tv_max_f32_dpp %2, %2, %2 row_half_mirror row_mask:0xf bank_mask:0xf\n\tv_max_f32_dpp %3, %3, %3 row_half_mirror row_mask:0xf bank_mask:0xf\n\tv_max_f32_dpp %4, %4, %4 row_half_mirror row_mask:0xf bank_mask:0xf\n\tv_max_f32_dpp %5, %5, %5 row_half_mirror row_mask:0xf bank_mask:0xf\n\tv_max_f32_dpp %6, %6, %6 row_half_mirror row_mask:0xf bank_mask:0xf\n\tv_max_f32_dpp %7, %7, %7 row_half_mirror row_mask:0xf bank_mask:0xf\n\t" : "+v"(m[0]), "+v"(m[1]), "+v"(m[2]), "+v"(m[3]), "+v"(m[4]), "+v"(m[5]), "+v"(m[6]), "+v"(m[7]));
        asm volatile("s_nop 1\n\tv_max_f32_dpp %0, %0, %0 row_mirror row_mask:0xf bank_mask:0xf\n\tv_max_f32_dpp %1, %1, %1 row_mirror row_mask:0xf bank_mask:0xf\n\tv_max_f32_dpp %2, %2, %2 row_mirror row_mask:0xf bank_mask:0xf\n\tv_max_f32_dpp %3, %3, %3 row_mirror row_mask:0xf bank_mask:0xf\n\tv_max_f32_dpp %4, %4, %4 row_mirror row_mask:0xf bank_mask:0xf\n\tv_max_f32_dpp %5, %5, %5 row_mirror row_mask:0xf bank_mask:0xf\n\tv_max_f32_dpp %6, %6, %6 row_mirror row_mask:0xf bank_mask:0xf\n\tv_max_f32_dpp %7, %7, %7 row_mirror row_mask:0xf bank_mask:0xf\n\t" : "+v"(m[0]), "+v"(m[1]), "+v"(m[2]), "+v"(m[3]), "+v"(m[4]), "+v"(m[5]), "+v"(m[6]), "+v"(m[7]));
    } else {
#pragma unroll
        for (int r = 0; r < N; ++r) m[r] = fmaxf(m[r], dppf<0xB1>(m[r]));
#pragma unroll
        for (int r = 0; r < N; ++r) m[r] = fmaxf(m[r], dppf<0x4E>(m[r]));
#pragma unroll
        for (int r = 0; r < N; ++r) m[r] = fmaxf(m[r], dppf<0x141>(m[r]));
#pragma unroll
        for (int r = 0; r < N; ++r) m[r] = fmaxf(m[r], dppf<0x140>(m[r]));
    }
#pragma unroll
    for (int r = 0; r < N; ++r) m[r] = fmaxf(m[r], __int_as_float(__builtin_amdgcn_ds_swizzle(__float_as_int(m[r]), 0x401F)));
}
#define TK_CE(a, b) { const float t_ = fmaxf(a, b); b = fminf(a, b); a = t_; }
#define TK_SORT16(v, o) { TK_CE(v[(o) + 0], v[(o) + 1]) TK_CE(v[(o) + 2], v[(o) + 3]) TK_CE(v[(o) + 4], v[(o) + 5]) TK_CE(v[(o) + 6], v[(o) + 7]) TK_CE(v[(o) + 8], v[(o) + 9]) TK_CE(v[(o) + 10], v[(o) + 11]) TK_CE(v[(o) + 12], v[(o) + 13]) TK_CE(v[(o) + 14], v[(o) + 15]) TK_CE(v[(o) + 0], v[(o) + 2]) TK_CE(v[(o) + 1], v[(o) + 3]) TK_CE(v[(o) + 4], v[(o) + 6]) TK_CE(v[(o) + 5], v[(o) + 7]) TK_CE(v[(o) + 8], v[(o) + 10]) TK_CE(v[(o) + 9], v[(o) + 11]) TK_CE(v[(o) + 12], v[(o) + 14]) TK_CE(v[(o) + 13], v[(o) + 15]) TK_CE(v[(o) + 1], v[(o) + 2]) TK_CE(v[(o) + 5], v[(o) + 6]) TK_CE(v[(o) + 9], v[(o) + 10]) TK_CE(v[(o) + 13], v[(o) + 14]) TK_CE(v[(o) + 0], v[(o) + 4]) TK_CE(v[(o) + 1], v[(o) + 5]) TK_CE(v[(o) + 2], v[(o) + 6]) TK_CE(v[(o) + 3], v[(o) + 7]) TK_CE(v[(o) + 8], v[(o) + 12]) TK_CE(v[(o) + 9], v[(o) + 13]) TK_CE(v[(o) + 10], v[(o) + 14]) TK_CE(v[(o) + 11], v[(o) + 15]) TK_CE(v[(o) + 2], v[(o) + 4]) TK_CE(v[(o) + 3], v[(o) + 5]) TK_CE(v[(o) + 10], v[(o) + 12]) TK_CE(v[(o) + 11], v[(o) + 13]) TK_CE(v[(o) + 1], v[(o) + 2]) TK_CE(v[(o) + 3], v[(o) + 4]) TK_CE(v[(o) + 5], v[(o) + 6]) TK_CE(v[(o) + 9], v[(o) + 10]) TK_CE(v[(o) + 11], v[(o) + 12]) TK_CE(v[(o) + 13], v[(o) + 14]) TK_CE(v[(o) + 0], v[(o) + 8]) TK_CE(v[(o) + 1], v[(o) + 9]) TK_CE(v[(o) + 2], v[(o) + 10]) TK_CE(v[(o) + 3], v[(o) + 11]) TK_CE(v[(o) + 4], v[(o) + 12]) TK_CE(v[(o) + 5], v[(o) + 13]) TK_CE(v[(o) + 6], v[(o) + 14]) TK_CE(v[(o) + 7], v[(o) + 15]) TK_CE(v[(o) + 4], v[(o) + 8]) TK_CE(v[(o) + 5], v[(o) + 9]) TK_CE(v[(o) + 6], v[(o) + 10]) TK_CE(v[(o) + 7], v[(o) + 11]) TK_CE(v[(o) + 2], v[(o) + 4]) TK_CE(v[(o) + 3], v[(o) + 5]) TK_CE(v[(o) + 6], v[(o) + 8]) TK_CE(v[(o) + 7], v[(o) + 9]) TK_CE(v[(o) + 10], v[(o) + 12]) TK_CE(v[(o) + 11], v[(o) + 13]) TK_CE(v[(o) + 1], v[(o) + 2]) TK_CE(v[(o) + 3], v[(o) + 4]) TK_CE(v[(o) + 5], v[(o) + 6]) TK_CE(v[(o) + 7], v[(o) + 8]) TK_CE(v[(o) + 9], v[(o) + 10]) TK_CE(v[(o) + 11], v[(o) + 12]) TK_CE(v[(o) + 13], v[(o) + 14]) }
#define TK_BM4(v, o) { TK_CE(v[(o) + 0], v[(o) + 2]) TK_CE(v[(o) + 1], v[(o) + 3]) TK_CE(v[(o) + 0], v[(o) + 1]) TK_CE(v[(o) + 2], v[(o) + 3]) }
#define TK_BM8(v, o) { TK_CE(v[(o) + 0], v[(o) + 4]) TK_CE(v[(o) + 1], v[(o) + 5]) TK_CE(v[(o) + 2], v[(o) + 6]) TK_CE(v[(o) + 3], v[(o) + 7]) TK_CE(v[(o) + 0], v[(o) + 2]) TK_CE(v[(o) + 1], v[(o) + 3]) TK_CE(v[(o) + 4], v[(o) + 6]) TK_CE(v[(o) + 5], v[(o) + 7]) TK_CE(v[(o) + 0], v[(o) + 1]) TK_CE(v[(o) + 2], v[(o) + 3]) TK_CE(v[(o) + 4], v[(o) + 5]) TK_CE(v[(o) + 6], v[(o) + 7]) }
#define TK_BM16(v, o) { TK_CE(v[(o) + 0], v[(o) + 8]) TK_CE(v[(o) + 1], v[(o) + 9]) TK_CE(v[(o) + 2], v[(o) + 10]) TK_CE(v[(o) + 3], v[(o) + 11]) TK_CE(v[(o) + 4], v[(o) + 12]) TK_CE(v[(o) + 5], v[(o) + 13]) TK_CE(v[(o) + 6], v[(o) + 14]) TK_CE(v[(o) + 7], v[(o) + 15]) TK_CE(v[(o) + 0], v[(o) + 4]) TK_CE(v[(o) + 1], v[(o) + 5]) TK_CE(v[(o) + 2], v[(o) + 6]) TK_CE(v[(o) + 3], v[(o) + 7]) TK_CE(v[(o) + 8], v[(o) + 12]) TK_CE(v[(o) + 9], v[(o) + 13]) TK_CE(v[(o) + 10], v[(o) + 14]) TK_CE(v[(o) + 11], v[(o) + 15]) TK_CE(v[(o) + 0], v[(o) + 2]) TK_CE(v[(o) + 1], v[(o) + 3]) TK_CE(v[(o) + 4], v[(o) + 6]) TK_CE(v[(o) + 5], v[(o) + 7]) TK_CE(v[(o) + 8], v[(o) + 10]) TK_CE(v[(o) + 9], v[(o) + 11]) TK_CE(v[(o) + 12], v[(o) + 14]) TK_CE(v[(o) + 13], v[(o) + 15]) TK_CE(v[(o) + 0], v[(o) + 1]) TK_CE(v[(o) + 2], v[(o) + 3]) TK_CE(v[(o) + 4], v[(o) + 5]) TK_CE(v[(o) + 6], v[(o) + 7]) TK_CE(v[(o) + 8], v[(o) + 9]) TK_CE(v[(o) + 10], v[(o) + 11]) TK_CE(v[(o) + 12], v[(o) + 13]) TK_CE(v[(o) + 14], v[(o) + 15]) }
__device__ __forceinline__ void tk_side(const f32x16 (&acc)[4], unsigned hi4, float (&L)[16]) {
    float s[64];
#pragma unroll
    for (int kb = 0; kb < 4; ++kb)
#pragma unroll
        for (int r = 0; r < 16; ++r) s[16 * kb + r] = __uint_as_float(((__float_as_uint(acc[kb][r]) & ~127u) | hi4) | (unsigned)(32 * kb + (r & 3) + 8 * (r >> 2)));
    TK_SORT16(s, 0) TK_SORT16(s, 16) TK_SORT16(s, 32) TK_SORT16(s, 48)
#pragma unroll
    for (int i = 0; i < 16; ++i) { s[i] = fmaxf(s[i], s[31 - i]); s[32 + i] = fmaxf(s[32 + i], s[63 - i]); }
    TK_BM16(s, 0) TK_BM16(s, 32)
#pragma unroll
    for (int i = 0; i < 16; ++i) s[i] = fmaxf(s[i], s[47 - i]);
    TK_BM16(s, 0)
#pragma unroll
    for (int i = 0; i < 16; ++i) s[16 + i] = __shfl_xor(s[15 - i], 32);
#pragma unroll
    for (int i = 0; i < 16; ++i) s[i] = fmaxf(s[i], s[16 + i]);
    TK_BM16(s, 0)
#pragma unroll
    for (int i = 0; i < 16; ++i) L[i] = s[i];
}
__device__ __forceinline__ void peer_topk_task(Frame& F, int l, int tg, int h) {
    const int lane = F.lane, n = lane & 31, hi = lane >> 5; unsigned char* lw = F.ws + WS_W + (size_t)l * LW_BYTES;
    const bf16* QP = (const bf16*)(F.ws + WS_QP); int* EIDX = (int*)(F.ws + WS_EIDX); float* EGATE = (float*)(F.ws + WS_EGATE);
    float L1[16], L2[16];
#pragma unroll
    for (int sd = 0; sd < 2; ++sd) {
        bf16x8 af[8];
#pragma unroll
        for (int kk = 0; kk < 8; ++kk) af[kk] = *(const bf16x8*)(QP + (size_t)(32 * tg + n) * 2048 + h * 256 + sd * 128 + kk * 16 + hi * 8);
        const bf16* SK = (const bf16*)(lw + (sd ? LW_SK2 : LW_SK1)) + (size_t)h * 128 * 128;
        f32x16 acc[4];
#pragma unroll
        for (int kb = 0; kb < 4; ++kb) { f32x16 z = {}; acc[kb] = z;
#pragma unroll
            for (int kk = 0; kk < 8; ++kk) { const bf16x8 bfr = *(const bf16x8*)(SK + (size_t)(32 * kb + n) * 128 + kk * 16 + hi * 8); acc[kb] = MFMA32(bfr, af[kk], acc[kb]); } }
        if (sd == 0) tk_side(acc, (unsigned)hi << 2, L1); else tk_side(acc, (unsigned)hi << 2, L2);
    }
    LAS unsigned char* tb = F.lds + F.wave * 8192 + lane * 40;
#pragma unroll
    for (int q = 0; q < 4; ++q) {
        const unsigned w1 = (__float_as_uint(L1[15 - 4 * q]) & 127u) | ((__float_as_uint(L1[14 - 4 * q]) & 127u) << 8) | ((__float_as_uint(L1[13 - 4 * q]) & 127u) << 16) | ((__float_as_uint(L1[12 - 4 * q]) & 127u) << 24);
        const unsigned w2 = (__float_as_uint(L2[15 - 4 * q]) & 127u) | ((__float_as_uint(L2[14 - 4 * q]) & 127u) << 8) | ((__float_as_uint(L2[13 - 4 * q]) & 127u) << 16) | ((__float_as_uint(L2[12 - 4 * q]) & 127u) << 24);
        *(LAS unsigned*)(tb + 4 * q) = w1; *(LAS unsigned*)(tb + 16 + 4 * q) = w2; }
    float A[16], B[16];
#pragma unroll
    for (int i = 0; i < 16; ++i) { A[i] = __uint_as_float(__float_as_uint(L1[i]) & ~127u); B[i] = __uint_as_float(__float_as_uint(L2[i]) & ~127u); }
#define TK_C(i, j) __uint_as_float((__float_as_uint(A[i] + B[j]) & ~255u) | (unsigned)(((15 - (i)) << 4) | (15 - (j))))
    const float NI = -INFINITY;
    float t1[16], x1[16], x2[16], y[8], z[8];
#pragma unroll
    for (int j = 0; j < 16; ++j) t1[j] = TK_C(0, j);
#pragma unroll
    for (int j = 0; j < 8; ++j) { x1[j] = TK_C(1, j); x1[8 + j] = TK_C(15 - j, 0); }
    TK_BM16(x1, 0)
    y[0] = TK_C(3, 0); y[1] = TK_C(3, 1); y[2] = TK_C(3, 2); y[3] = TK_C(3, 3); y[4] = NI; y[5] = TK_C(4, 2); y[6] = TK_C(4, 1); y[7] = TK_C(4, 0);
    TK_BM8(y, 0)
    x2[0] = TK_C(2, 0); x2[1] = TK_C(2, 1); x2[2] = TK_C(2, 2); x2[3] = TK_C(2, 3); x2[4] = TK_C(2, 4); x2[5] = NI; x2[6] = NI; x2[7] = NI;
#pragma unroll
    for (int p = 0; p < 8; ++p) x2[8 + p] = y[7 - p];
    TK_BM16(x2, 0)
    z[0] = TK_C(5, 0); z[1] = TK_C(5, 1); z[2] = TK_C(6, 1); z[3] = TK_C(6, 0);
    TK_BM4(z, 0)
    z[4] = NI; z[5] = NI; z[6] = TK_C(7, 1); z[7] = TK_C(7, 0);
    TK_BM8(z, 0)
#pragma unroll
    for (int i = 0; i < 16; ++i) t1[i] = fmaxf(t1[i], x1[15 - i]);
    TK_BM16(t1, 0)
#pragma unroll
    for (int i = 8; i < 16; ++i) x2[i] = fmaxf(x2[i], z[15 - i]);
    TK_BM16(x2, 0)
#pragma unroll
    for (int i = 0; i < 16; ++i) t1[i] = fmaxf(t1[i], x2[15 - i]);
    TK_BM16(t1, 0)
#undef TK_C
    const float v0 = __uint_as_float(__float_as_uint(t1[0]) & ~255u);
    float ex[16]; float sum = 0.f;
#pragma unroll
    for (int k = 0; k < 16; ++k) { ex[k] = __expf(__uint_as_float(__float_as_uint(t1[k]) & ~255u) - v0); sum += ex[k]; }
    const float inv = 1.0f / sum;
    LDS_WAIT(); asm volatile("" ::: "memory");
    unsigned o[16];
#pragma unroll
    for (int k = 0; k < 16; ++k) { const unsigned id = __float_as_uint(t1[k]) & 255u;
        const unsigned i1 = *(LAS unsigned char*)(tb + (id >> 4)), i2 = *(LAS unsigned char*)(tb + 16 + (id & 15u));
        o[k] = hi ? __float_as_uint(ex[k] * inv) : (i1 * 128u + i2); }
    unsigned* dst = (hi ? (unsigned*)EGATE : (unsigned*)EIDX) + ((size_t)32 * tg + n) * 128 + h * 16;
#pragma unroll
    for (int q = 0; q < 4; ++q) *(v4u*)(dst + 4 * q) = (v4u){o[4 * q], o[4 * q + 1], o[4 * q + 2], o[4 * q + 3]};
}
typedef unsigned ps_v3u __attribute__((ext_vector_type(3))); typedef unsigned ps_v6u __attribute__((ext_vector_type(6))); typedef float ps_v32f __attribute__((ext_vector_type(32)));
__device__ __forceinline__ float dpp_add8(float v) {
    v += dppf<0xB1>(v); v += dppf<0x4E>(v); v += dppf<0x141>(v); return v;
}
constexpr int PS_LD = 132;
__device__ __forceinline__ void peer_u_slice(Frame& F, int l, int x, int ci) {
    const int lane = F.lane, eo = lane >> 3, cl = lane & 7; unsigned char* lw = F.ws + WS_W + (size_t)l * LW_BYTES;
    const unsigned char* U = lw + LW_U + (size_t)x * 16384 * 192; const bf16* HN = (const bf16*)(F.ws + WS_HN); const int* EIDX = (const int*)(F.ws + WS_EIDX);
    float* AP = (float*)(F.ws + WS_ACT) + (size_t)x * NTOK * 128; LAS int* E = (LAS int*)(F.lds + RING_OFF + F.wave * 16384);
    const int t0 = 256 * ci + 32 * F.wave;
    v4u xw[4]; int er[2]; float po0 = 0.f, po1 = 0.f;
    { const v4u* xp = (const v4u*)(HN + (size_t)t0 * 2048 + 256 * x + 32 * cl); xw[0] = xp[0]; xw[1] = xp[1]; xw[2] = xp[2]; xw[3] = xp[3]; er[0] = EIDX[(size_t)t0 * 128 + lane]; er[1] = EIDX[(size_t)t0 * 128 + 64 + lane]; }
#pragma nounroll
    for (int i = 0; i < 32; ++i) { const int t = t0 + i;
        E[lane] = er[0]; E[64 + lane] = er[1];
        float xs[32];
#pragma unroll
        for (int q = 0; q < 4; ++q) { xs[8 * q] = bflo(xw[q].x); xs[8 * q + 1] = bfhi(xw[q].x); xs[8 * q + 2] = bflo(xw[q].y); xs[8 * q + 3] = bfhi(xw[q].y); xs[8 * q + 4] = bflo(xw[q].z); xs[8 * q + 5] = bfhi(xw[q].z); xs[8 * q + 6] = bflo(xw[q].w); xs[8 * q + 7] = bfhi(xw[q].w); }
        LDS_WAIT(); asm volatile("" ::: "memory");
        ps_v3u r[16][2];
#pragma unroll
        for (int b = 0; b < 16; ++b) { const unsigned o = (unsigned)E[8 * b + eo] * 192u + 24u * (unsigned)cl; r[b][0] = *(const ps_v3u*)(U + (size_t)o); r[b][1] = *(const ps_v3u*)(U + (size_t)o + 12); }
        if (i > 0) { AP[(size_t)(t - 1) * 128 + 8 * cl + eo] = po0; AP[(size_t)(t - 1) * 128 + 64 + 8 * cl + eo] = po1; }
        if (i < 31) { const v4u* xp = (const v4u*)(HN + (size_t)(t + 1) * 2048 + 256 * x + 32 * cl); xw[0] = xp[0]; xw[1] = xp[1]; xw[2] = xp[2]; xw[3] = xp[3]; er[0] = EIDX[(size_t)(t + 1) * 128 + lane]; er[1] = EIDX[(size_t)(t + 1) * 128 + 64 + lane]; }
        float d[16];
#pragma unroll
        for (int b = 0; b < 16; ++b) { unsigned p0 = r[b][0].x; if (b >= 1) asm volatile("" : "+v"(p0), "+v"(d[b - 1]));
            const ps_v32f f = __builtin_amdgcn_cvt_scalef32_pk32_f32_fp6((ps_v6u){p0, r[b][0].y, r[b][0].z, r[b][1].x, r[b][1].y, r[b][1].z}, 1.0f);
            f32x2 s0 = {0.f, 0.f}, s1 = {0.f, 0.f}, s2 = {0.f, 0.f}, s3 = {0.f, 0.f};
#pragma unroll
            for (int q = 0; q < 32; q += 8) { s0 += (f32x2){f[q], f[q + 1]} * (f32x2){xs[q], xs[q + 1]}; s1 += (f32x2){f[q + 2], f[q + 3]} * (f32x2){xs[q + 2], xs[q + 3]}; s2 += (f32x2){f[q + 4], f[q + 5]} * (f32x2){xs[q + 4], xs[q + 5]}; s3 += (f32x2){f[q + 6], f[q + 7]} * (f32x2){xs[q + 6], xs[q + 7]}; }
            const f32x2 s = (s0 + s1) + (s2 + s3); d[b] = dpp_add8(s.x + s.y); }
        po0 = cl == 0 ? d[0] : cl == 1 ? d[1] : cl == 2 ? d[2] : cl == 3 ? d[3] : cl == 4 ? d[4] : cl == 5 ? d[5] : cl == 6 ? d[6] : d[7];
        po1 = cl == 0 ? d[8] : cl == 1 ? d[9] : cl == 2 ? d[10] : cl == 3 ? d[11] : cl == 4 ? d[12] : cl == 5 ? d[13] : cl == 6 ? d[14] : d[15];
    }
    AP[(size_t)(t0 + 31) * 128 + 8 * cl + eo] = po0; AP[(size_t)(t0 + 31) * 128 + 64 + 8 * cl + eo] = po1;
}
__device__ __forceinline__ void peer_weights(Frame& F, int l, int tg) {
    unsigned char* lw = F.ws + WS_W + (size_t)l * LW_BYTES; const int* EIDX = (const int*)(F.ws + WS_EIDX); const float* EGATE = (const float*)(F.ws + WS_EGATE);
    const float* SU = (const float*)(lw + LW_SU); const float* SV = (const float*)(lw + LW_SV); const float* AP = (const float*)(F.ws + WS_ACT); v2u* EWG = (v2u*)(F.ws + WS_ACT + (size_t)8 * NTOK * 128 * 4);
#pragma nounroll
    for (int k0 = 0; k0 < 8; k0 += 4) { float pa[4][8]; int er[4]; float eg[4], su[4], sv[4];
#pragma unroll
        for (int j = 0; j < 4; ++j) { const size_t p = (size_t)tg * 4096 + (k0 + j) * 512 + F.tid; er[j] = EIDX[p]; eg[j] = EGATE[p];
#pragma unroll
            for (int s = 0; s < 8; ++s) pa[j][s] = AP[(size_t)s * NTOK * 128 + p]; }
#pragma unroll
        for (int j = 0; j < 4; ++j) { su[j] = SU[er[j]]; sv[j] = SV[er[j]]; }
#pragma unroll
        for (int j = 0; j < 4; ++j) { const size_t p = (size_t)tg * 4096 + (k0 + j) * 512 + F.tid; const float a = ((pa[j][0] + pa[j][1]) + (pa[j][2] + pa[j][3])) + ((pa[j][4] + pa[j][5]) + (pa[j][6] + pa[j][7]));
            EWG[p] = (v2u){(unsigned)er[j], __float_as_uint(eg[j] * pg8::gelu1(a * su[j]) * sv[j])}; } }
}
__device__ __forceinline__ void peer_v_slice(Frame& F, int l, int x, int ci) {
    const int lane = F.lane, tk = lane >> 3, cl = lane & 7; unsigned char* lw = F.ws + WS_W + (size_t)l * LW_BYTES;
    const unsigned char* V = lw + LW_V + (size_t)x * 16384 * 192;
    const v2u* EWG = (const v2u*)(F.ws + WS_ACT + (size_t)8 * NTOK * 128 * 4);
    const bf16* XA = (const bf16*)(F.ws + WS_XA); bf16* XB = (bf16*)(F.ws + WS_XB);
    LAS v2u* EW = (LAS v2u*)(F.lds + RING_OFF + F.wave * 16384);
#pragma nounroll
    for (int g = 0; g < 4; ++g) { const int tb = 256 * ci + 32 * F.wave + 8 * g, t = tb + tk;
        { v2u ew[16];
#pragma unroll
          for (int jj = 0; jj < 16; ++jj) ew[jj] = EWG[(size_t)tb * 128 + jj * 64 + lane];
#pragma unroll
          for (int jj = 0; jj < 16; ++jj) { const int p = jj * 64 + lane; EW[(p >> 7) * PS_LD + (p & 127)] = ew[jj]; } }
        v4u xr[4]; { const v4u* xp = (const v4u*)(XA + (size_t)t * 2048 + 256 * x + 32 * cl); xr[0] = xp[0]; xr[1] = xp[1]; xr[2] = xp[2]; xr[3] = xp[3]; }
        LDS_WAIT(); asm volatile("" ::: "memory");
        ps_v3u r[8][2]; float wr[8];
#define PB_REQ(k, e) { const v2u ew = EW[tk * PS_LD + (e)]; const unsigned o = ew.x * 192u + 24u * (unsigned)cl; r[k][0] = *(const ps_v3u*)(V + (size_t)o); r[k][1] = *(const ps_v3u*)(V + (size_t)o + 12); wr[k] = __uint_as_float(ew.y); }
#pragma unroll
        for (int k = 0; k < 8; ++k) PB_REQ(k, k)
        f32x2 acc[16];
#pragma unroll
        for (int q = 0; q < 16; ++q) acc[q] = (f32x2){0.f, 0.f};
#pragma nounroll
        for (int eb = 0; eb < 16; ++eb) {
#pragma unroll
            for (int k = 0; k < 8; ++k) { unsigned p0 = r[k][0].x; const float w = wr[k];
                asm volatile("" : "+v"(p0), "+v"(acc[0]), "+v"(acc[1]), "+v"(acc[2]), "+v"(acc[3]), "+v"(acc[4]), "+v"(acc[5]), "+v"(acc[6]), "+v"(acc[7]), "+v"(acc[8]), "+v"(acc[9]), "+v"(acc[10]), "+v"(acc[11]), "+v"(acc[12]), "+v"(acc[13]), "+v"(acc[14]), "+v"(acc[15]));
                const ps_v32f f = __builtin_amdgcn_cvt_scalef32_pk32_f32_fp6((ps_v6u){p0, r[k][0].y, r[k][0].z, r[k][1].x, r[k][1].y, r[k][1].z}, 1.0f);
                if (eb < 15) PB_REQ(k, 8 * eb + 8 + k)
                const f32x2 w2 = {w, w};
#pragma unroll
                for (int q = 0; q < 16; ++q) acc[q] += w2 * (f32x2){f[2 * q], f[2 * q + 1]}; } }
#undef PB_REQ
        v4u po[4];
#pragma unroll
        for (int q = 0; q < 4; ++q) { const v4u w = xr[q];
            po[q] = (v4u){pk2(acc[4 * q].x + bflo(w.x), acc[4 * q].y + bfhi(w.x)), pk2(acc[4 * q + 1].x + bflo(w.y), acc[4 * q + 1].y + bfhi(w.y)), pk2(acc[4 * q + 2].x + bflo(w.z), acc[4 * q + 2].y + bfhi(w.z)), pk2(acc[4 * q + 3].x + bflo(w.w), acc[4 * q + 3].y + bfhi(w.w))}; }
        { v4u* op = (v4u*)(XB + (size_t)t * 2048 + 256 * x + 32 * cl); op[0] = po[0]; op[1] = po[1]; op[2] = po[2]; op[3] = po[3]; }
    }
}
__device__ __forceinline__ void rms_rows_out(int lane, const bf16* X, const float* gain, float* O, int m0, int step, int M) {
    f32x4 g[8];
#pragma unroll
    for (int j = 0; j < 8; ++j) g[j] = *((const f32x4*)gain + lane + 64 * j);
    v2u rb[8];
#define RO_LOAD(m) { _Pragma("unroll") for (int j = 0; j < 8; ++j) rb[j] = *((const v2u*)(X + (size_t)(m) * 2048) + lane + 64 * j); }
    if (m0 < M) RO_LOAD(m0)
#pragma nounroll
    for (int m = m0; m < M; m += step) { f32x4 v[8]; float s = 0.f;
#pragma unroll
        for (int j = 0; j < 8; ++j) { v[j] = (f32x4){bflo(rb[j].x), bfhi(rb[j].x), bflo(rb[j].y), bfhi(rb[j].y)}; s += (v[j].x * v[j].x + v[j].y * v[j].y) + (v[j].z * v[j].z + v[j].w * v[j].w); }
        if (m + step < M) RO_LOAD(m + step)
        const float rstd = 1.0f / sqrtf(wave_sum(s) * (1.f / 2048.f) + RMS_EPS);
#pragma unroll
        for (int j = 0; j < 8; ++j) *((f32x4*)(O + (size_t)m * 2048) + lane + 64 * j) = v[j] * rstd * g[j]; }
#undef RO_LOAD
}
#ifdef USE_PG8
#define GEMM_CALL(E, S) pg8::gemm_phase<E, S, true, true>
#else
#define GEMM_CALL(E, S) pg8::gemm_simple<E, S>
#endif
#ifndef DBLJ
#define DBLJ -1
#define DBLL 1
#endif
constexpr int PH_PER_LAYER = 12, NPH = 2 + NLAYER * PH_PER_LAYER;
struct Args { const float* in[23]; float* out; unsigned char* ws; int ph_lo, ph_hi; };
__global__ void __launch_bounds__(NWAVES * 64, 2) hybrid_fwd(Args args) {
    extern __shared__ __attribute__((aligned(16))) unsigned char lds[];
    Frame F;
    F.lds = (LAS unsigned char*)lds; F.MISCW = (volatile LAS unsigned*)(F.lds + MISC_OFF);
    F.tid = threadIdx.x; F.lane = F.tid & 63; F.wave = __builtin_amdgcn_readfirstlane(F.tid >> 6);
    F.G = gridDim.x; { const int bx = blockIdx.x; F.vcu = (F.G % 8 == 0) ? (bx % 8) * (F.G / 8) + bx / 8 : bx; }
    F.ws = args.ws; F.ctl = (gu32*)(args.ws + WS_CTL); F.out = args.out;
    for (int u = F.tid; u < (LDS_BYTES - LDSCTL_OFF) / 4; u += NWAVES * 64) ((LAS unsigned*)(F.lds + LDSCTL_OFF))[u] = 0u;
    __syncthreads();
    const int lo = args.ph_lo, hi = args.ph_hi; const bool multi = (hi - lo) > 1;
    XcdBarrier bar; bar.bar = (unsigned*)(F.ctl + CW_BAR); bar.x = 0; bar.st = nullptr;
    if (multi) bar = xcd_barrier_post((unsigned*)(F.ctl + CW_BAR), F.MISCW + 8);
#ifndef PHM
#define PHM 0xfff
#endif
#define IN(k) (lo <= (k) && (k) < hi)
#define ON(j) ((PHM >> (j)) & 1)
#define SEAM(k) do { if (IN(k) && IN((k) + 1)) xcd_barrier(bar); } while (0)
    int bx = (int)blockIdx.x;
#define PH_BEGIN() do { asm volatile("" : "+v"(F.tid), "+v"(F.lane)); asm volatile("" : "+s"(F.wave), "+s"(bx), "+s"(F.ws)); } while (0)
    if (ON(0) && IN(0)) for (int rep_ = 0; rep_ < ((DBLJ == 11) ? 2 : 1); ++rep_) { if (rep_) xcd_barrier(bar); PH_BEGIN(); p0_int8_weights(F, args); PH_BEGIN(); p0_prologue(F, args); } SEAM(0);
    for (int l = 0; l < NLAYER; ++l) {
        const int pb = 2 + l * PH_PER_LAYER;
        if (ON(1) && IN(pb + 0)) for (int rep_ = 0; rep_ < ((DBLJ == 0 && l == DBLL) ? 2 : 1); ++rep_) { if (rep_) xcd_barrier(bar); PH_BEGIN(); unsigned char* lw = F.ws + WS_W + (size_t)l * LW_BYTES; (void)lw;
            { pg8::Gemm g{(const bf16*)(F.ws + WS_HN8), (const bf16*)(lw + LW_WIN), NTOK, NWIN, 1024}; pg8::StaticOrder S; S.init(NTOK, NWIN, F.G, bx);
              pg8::EpiWin E{(bf16*)(F.ws + WS_ACT), (bf16*)(F.ws + WS_GATE), (float*)(F.ws + WS_MISC), (bf16*)(F.ws + WS_VT), (const float*)(F.ws + WS_R16), (const float*)(F.ws + WS_SXH), (const float*)(lw + LW_SWIN)};
              pg8::gemm_phase<pg8::EpiWin, pg8::StaticOrder, true, true, true>(F.lds + RING_OFF, g, S, E); }
        } SEAM(pb + 0);
        if (ON(3) && IN(pb + 1)) for (int rep_ = 0; rep_ < ((DBLJ == 2 && l == DBLL) ? 2 : 1); ++rep_) { if (rep_) xcd_barrier(bar); PH_BEGIN(); unsigned char* lw = F.ws + WS_W + (size_t)l * LW_BYTES; (void)lw;
            if (bx < 224) {
                { const int N0 = bx < 96 ? 768 : 1024, G0 = bx < 96 ? 96 : 128, c0 = bx < 96 ? bx : bx - 96; pg8::StaticOrder S0; S0.init(NTOK, N0, G0, c0); pg8::Unit u0; (void)S0.next(0, u0);
                  if (bx < 96) p2_q_rows(F, args, l, 256 * u0.pm); else p2_kv_rows(F, args, l, 256 * u0.pm, u0.pn == 0 ? 1 : 0);
                  asm volatile("s_waitcnt vmcnt(0)" ::: "memory"); __syncthreads(); }
                asm volatile("" : "+v"(F.tid), "+v"(F.lane)); asm volatile("" : "+s"(F.wave), "+s"(bx), "+s"(F.ws));
                unsigned char* lw2 = F.ws + WS_W + (size_t)l * LW_BYTES;
                pg8::Gemm g{nullptr, nullptr, 0, 0, 0}; pg8::EpiGen E{nullptr, 0, 64, 0, 1 << 30, 0, 1 << 30, 1 << 30, (bf16*)(F.ws + WS_VT)}; int Gs = 0, cs = -1, M = 0, N = 0;
                if (bx < 96) { g = pg8::Gemm{(const bf16*)(F.ws + WS_CQN), (const bf16*)(lw2 + LW_WUQ), NTOK, 768, 512}; E.O = (bf16*)(F.ws + WS_QM); E.ld = 768; Gs = 96; cs = bx; M = NTOK; N = 768; }
                else { g = pg8::Gemm{(const bf16*)(F.ws + WS_CKVN), (const bf16*)(lw2 + LW_WUKV), NTOK, 1024, 256}; E.O = (bf16*)(F.ws + WS_KM); E.ld = 768; E.hs = 96; E.vt_split = 512; E.vt_row0 = R_MV; Gs = 128; cs = bx - 96; M = NTOK; N = 1024; }
                pg8::StaticOrder S; S.init(M, N, Gs, cs); GEMM_CALL(pg8::EpiGen, pg8::StaticOrder)(F.lds + RING_OFF, g, S, E); }
            else if (bx >= 224) { const int isv = (bx - 224) >> 4, c = (bx - 224) & 15;
                p2_cmp_rows(F, args, l, isv, c >> 2, c & 3); asm volatile("s_waitcnt vmcnt(0)" ::: "memory"); __syncthreads();
                pg8::Gemm g2{(const bf16*)(F.ws + (isv ? WS_ABV : WS_ABK)), (const bf16*)(lw + (isv ? LW_VCW1 : LW_KCW1)), 4096, 1024, 512}; pg8::SliceOrder S2{c};
                pg8::EpiPart E2{(float*)(F.ws + WS_Z) + (size_t)isv * 4 * 1024 * 256};
                GEMM_CALL(pg8::EpiPart, pg8::SliceOrder)(F.lds + RING_OFF, g2, S2, E2); }
            asm volatile("" : "+v"(F.tid), "+v"(F.lane)); asm volatile("" : "+s"(F.wave), "+s"(bx), "+s"(F.ws));
            p2_fox(F, args, l);
        } SEAM(pb + 1);
        if (ON(4) && IN(pb + 2)) for (int rep_ = 0; rep_ < ((DBLJ == 3 && l == DBLL) ? 2 : 1); ++rep_) { if (rep_) xcd_barrier(bar); PH_BEGIN(); unsigned char* lw = F.ws + WS_W + (size_t)l * LW_BYTES; (void)lw;
            const int bh = bx >> 3, j = bx & 7, b = bh >> 3, h = bh & 7; gu32* nsaflag = F.ctl + CW_NSAF + 64 * (2 * l + rep_);
            if (j == 6 && bh < 8) { const int isv = bh >> 2;
                {
                    const float* PT = (const float*)(F.ws + WS_Z) + (size_t)isv * 4 * 1024 * 256 + (size_t)(bh & 3) * 256 * 256; bf16* HO = (bf16*)(F.ws + (isv ? WS_HV : WS_HK)) + (size_t)(bh & 3) * 256 * 256;
                    f32x4 pt[4][4];
#define CP_LOAD(it) { _Pragma("unroll") for (int q = 0; q < 4; ++q) { const size_t idx = (size_t)F.tid + (size_t)NTHR * (4 * (it) + q); _Pragma("unroll") for (int sl = 0; sl < 4; ++sl) pt[q][sl] = *(const f32x4*)(PT + (size_t)sl * 1024 * 256 + idx * 4); } }
                    CP_LOAD(0)
#pragma nounroll
                    for (int it = 0; it < 8; ++it) { f32x4 sacc[4];
#pragma unroll
                        for (int q = 0; q < 4; ++q) sacc[q] = (pt[q][0] + pt[q][1]) + (pt[q][2] + pt[q][3]);
                        if (it < 7) CP_LOAD(it + 1)
#pragma unroll
                        for (int q = 0; q < 4; ++q) { const size_t idx = (size_t)F.tid + (size_t)NTHR * (4 * it + q);
                            const f32x2 g0 = pg8::gelu_pk((f32x2){sacc[q][0], sacc[q][1]}), g1 = pg8::gelu_pk((f32x2){sacc[q][2], sacc[q][3]});
                            *(v2u*)(HO + idx * 4) = (v2u){pk2(g0.x, g0.y), pk2(g1.x, g1.y)}; } }
#undef CP_LOAD
                    asm volatile("s_waitcnt vmcnt(0)" ::: "memory"); __syncthreads(); }
                pg8::Gemm g{(const bf16*)(F.ws + (isv ? WS_HV : WS_HK)), (const bf16*)(lw + (isv ? LW_VCW2 : LW_KCW2)), 1024, 256, 256}; pg8::StaticOrder S; S.init(1024, 256, 4, bh & 3);
                pg8::EpiCmp2 E{(bf16*)(F.ws + (isv ? WS_VCT : WS_KC)), isv ? 0 : 1, (const float*)(F.ws + WS_R16)};
                GEMM_CALL(pg8::EpiCmp2, pg8::StaticOrder)(F.lds + RING_OFF, g, S, E);
                asm volatile("s_waitcnt vmcnt(0)" ::: "memory"); __syncthreads();
                if (F.tid == 0) { __builtin_amdgcn_fence(__ATOMIC_RELEASE, "agent"); asm volatile("s_waitcnt vmcnt(0)" ::: "memory"); (void)__hip_atomic_fetch_add(nsaflag, 1u, RLX_AGENT); }
                __syncthreads(); }
            mla_unit(F, b, h, j);
#if UDBL == 1
            mla_unit(F, b, h, j);
#endif
            const unsigned foxm = j == 0 ? 0x0Eu : j == 1 ? 0x21u : j == 2 ? 0x80u : j == 4 ? 0x10u : j == 5 ? 0x40u : 0u;
            const unsigned sbm = j == 0 ? 0x03u : j == 1 ? 0x0Cu : j == 2 ? 0x30u : j == 3 ? 0xC0u : 0u;
#pragma nounroll
            for (int q = 0; q < 8; ++q) if ((foxm >> q) & 1u) fox_unit(F, l, b, h, q);
#pragma nounroll
            for (int q = 0; q < 8; ++q) if ((sbm >> q) & 1u) sb_unit(F, b, h, q);
#if UDBL == 3
#pragma nounroll
            for (int q = 0; q < 8; ++q) if ((sbm >> q) & 1u) sb_unit(F, b, h, q);
#endif
#if UDBL == 4
#pragma nounroll
            for (int q = 0; q < 8; ++q) if ((foxm >> q) & 1u) fox_unit(F, l, b, h, q);
#endif
            {
                if (F.tid == 0) { unsigned sp = 0; while (__hip_atomic_load(nsaflag, RLX_AGENT) < 8u) { __builtin_amdgcn_s_sleep(4); if (++sp > (1u << 22)) break; }
                    __builtin_amdgcn_fence(__ATOMIC_ACQUIRE, "agent"); asm volatile("s_waitcnt vmcnt(0)" ::: "memory"); }
                __syncthreads();
                const int ii = j < 4 ? j : 11 - j; nsa_unit(F, b, h >> 2, (h & 3) + 4 * ii);
#if UDBL == 2
                nsa_unit(F, b, h >> 2, (h & 3) + 4 * ii);
#endif
            }
        } SEAM(pb + 2);
        if (ON(6) && IN(pb + 3)) for (int rep_ = 0; rep_ < ((DBLJ == 5 && l == DBLL) ? 2 : 1); ++rep_) { if (rep_) xcd_barrier(bar); PH_BEGIN(); unsigned char* lw = F.ws + WS_W + (size_t)l * LW_BYTES; (void)lw;
            pg8::Gemm g{(const bf16*)(F.ws + WS_BR), (const bf16*)(lw + LW_WBR), 4 * NTOK, 4 * 2048, 512}; pg8::BranchOrder S{F.G, bx};
            pg8::EpiBranch E{(const bf16*)(F.ws + WS_GATE), (bf16*)(F.ws + WS_ZF), (bf16*)(F.ws + WS_Z)};
            GEMM_CALL(pg8::EpiBranch, pg8::BranchOrder)(F.lds + RING_OFF, g, S, E);
        } SEAM(pb + 3);
        if (ON(7) && IN(pb + 4)) for (int rep_ = 0; rep_ < ((DBLJ == 6 && l == DBLL) ? 2 : 1); ++rep_) { if (rep_) xcd_barrier(bar); PH_BEGIN(); unsigned char* lw = F.ws + WS_W + (size_t)l * LW_BYTES; (void)lw;
            pg8::Gemm g{(const bf16*)(F.ws + WS_Z), (const bf16*)(lw + LW_WOUT), NTOK, 2048, 2048}; pg8::StaticOrder S; S.init(NTOK, 2048, F.G, bx);
            pg8::EpiResid E{l == 0 ? args.in[0] : nullptr, l == 0 ? nullptr : (const bf16*)(F.ws + WS_XB), (bf16*)(F.ws + WS_XA)};
            GEMM_CALL(pg8::EpiResid, pg8::StaticOrder)(F.lds + RING_OFF, g, S, E);
        } SEAM(pb + 4);
        if (ON(8) && IN(pb + 5)) for (int rep_ = 0; rep_ < ((DBLJ == 7 && l == DBLL) ? 2 : 1); ++rep_) { if (rep_) xcd_barrier(bar); PH_BEGIN(); unsigned char* lw = F.ws + WS_W + (size_t)l * LW_BYTES; (void)lw; const int gw = F.vcu * NWAVES + F.wave, NGW = F.G * NWAVES;
            rms_rows<true>(F.lane, F.ws + WS_XA, args.in[16] + (size_t)l * 2048, (bf16*)(F.ws + WS_HN), (signed char*)(F.ws + WS_HN8), (float*)(F.ws + WS_SXH), gw, NGW, NTOK);
        } SEAM(pb + 5);
        if (ON(9) && IN(pb + 6)) for (int rep_ = 0; rep_ < ((DBLJ == 8 && l == DBLL) ? 2 : 1); ++rep_) { if (rep_) xcd_barrier(bar); PH_BEGIN(); unsigned char* lw = F.ws + WS_W + (size_t)l * LW_BYTES; (void)lw;
#ifdef P9_BF16
            pg8::Gemm g{(const bf16*)(F.ws + WS_HN), (const bf16*)(lw + LW_WQB), NTOK, 2048, 2048}; pg8::StaticOrder S; S.init(NTOK, 2048, F.G, bx);
            pg8::EpiGen E{(bf16*)(F.ws + WS_QP), 2048, 64, 0, 1 << 30, 0, 1 << 30, 1 << 30, (bf16*)(F.ws + WS_VT)};
            GEMM_CALL(pg8::EpiGen, pg8::StaticOrder)(F.lds + RING_OFF, g, S, E);
#else
            pg8::Gemm g{(const bf16*)(F.ws + WS_HN8), (const bf16*)(lw + LW_WQ), NTOK, 2048, 1024}; pg8::StaticOrder S; S.init(NTOK, 2048, F.G, bx);
            pg8::EpiQ8 E{(bf16*)(F.ws + WS_QP), 2048, (const float*)(F.ws + WS_SXH), (const float*)(lw + LW_SWQ)};
            pg8::gemm_phase<pg8::EpiQ8, pg8::StaticOrder, true, true, true>(F.lds + RING_OFF, g, S, E);
#endif
        } SEAM(pb + 6);
        if (ON(10) && IN(pb + 7)) for (int rep_ = 0; rep_ < ((DBLJ == 9 && l == DBLL) ? 2 : 1); ++rep_) { if (rep_) xcd_barrier(bar); PH_BEGIN();
            for (int tg = bx; tg < 256; tg += F.G) peer_topk_task(F, l, tg, F.wave);
        } SEAM(pb + 7);
        if (ON(10) && IN(pb + 8)) for (int rep_ = 0; rep_ < ((DBLJ == 12 && l == DBLL) ? 2 : 1); ++rep_) { if (rep_) xcd_barrier(bar); PH_BEGIN(); peer_u_slice(F, l, bx & 7, bx >> 3); } SEAM(pb + 8);
        if (ON(10) && IN(pb + 9)) { PH_BEGIN(); for (int tg = bx; tg < 256; tg += F.G) peer_weights(F, l, tg); } SEAM(pb + 9);
        if (ON(10) && IN(pb + 10)) for (int rep_ = 0; rep_ < ((DBLJ == 13 && l == DBLL) ? 2 : 1); ++rep_) { if (rep_) xcd_barrier(bar); PH_BEGIN(); peer_v_slice(F, l, bx & 7, bx >> 3); } SEAM(pb + 10);
        if (ON(10) && IN(pb + 11)) { PH_BEGIN(); const int gw = F.vcu * NWAVES + F.wave, NGW = F.G * NWAVES;
            if (l + 1 < NLAYER) rms_rows<true>(F.lane, F.ws + WS_XB, args.in[1] + (size_t)(l + 1) * 2048, (bf16*)(F.ws + WS_HN), (signed char*)(F.ws + WS_HN8), (float*)(F.ws + WS_SXH), gw, NGW, NTOK);
            else rms_rows_out(F.lane, (const bf16*)(F.ws + WS_XB), args.in[22], F.out, gw, NGW, NTOK);
        } SEAM(pb + 11);
    }
#undef IN
#undef SEAM
}

extern "C" void kernel_launch(void* const* d_in, const int* in_sizes, int n_in, void* d_out, int out_size, void* d_ws, size_t ws_size, hipStream_t stream) {
    static int grid = 0;
    if (grid == 0) {
        if (n_in != 23 || out_size != NTOK * 2048 || ws_size < WS_END) { fprintf(stderr, "kernel_launch: unexpected shapes (n_in %d, out %d, ws %zu < %zu); nothing launched\n", n_in, out_size, ws_size, (size_t)WS_END); grid = -1; return; }
        int dev = 0, cus = 0, per_cu = 0;
        if (hipGetDevice(&dev) != hipSuccess || hipDeviceGetAttribute(&cus, hipDeviceAttributeMultiprocessorCount, dev) != hipSuccess) { grid = -1; return; }
        if (hipFuncSetAttribute((const void*)hybrid_fwd, hipFuncAttributeMaxDynamicSharedMemorySize, LDS_BYTES) != hipSuccess) { fprintf(stderr, "kernel_launch: hipFuncSetAttribute failed\n"); grid = -1; return; }
        if (hipOccupancyMaxActiveBlocksPerMultiprocessor(&per_cu, (const void*)hybrid_fwd, NWAVES * 64, LDS_BYTES) != hipSuccess || per_cu < 1) fprintf(stderr, "kernel_launch: occupancy query reports %d blocks per CU\n", per_cu);
        (void)hipGetLastError();
        grid = 256;
        if (grid != 256) fprintf(stderr, "kernel_launch: %d CUs; this kernel's unit maps assume 256\n", grid);
    }
    if (grid < 0) return;
    (void)hipMemsetAsync((char*)d_ws + WS_CTL, 0, CTL_ZERO_BYTES, stream);
    Args a{};
    for (int i = 0; i < 23; ++i) a.in[i] = (const float*)d_in[i];
    a.out = (float*)d_out; a.ws = (unsigned char*)d_ws;
#ifndef ONE_LAUNCH
#define ONE_LAUNCH 0
#endif
    if (ONE_LAUNCH) { a.ph_lo = 0; a.ph_hi = NPH; hipLaunchKernelGGL(hybrid_fwd, dim3(grid), dim3(NWAVES * 64), LDS_BYTES, stream, a); }
    else for (int p = 0; p < NPH; ++p) { a.ph_lo = p; a.ph_hi = p + 1; hipLaunchKernelGGL(hybrid_fwd, dim3(grid), dim3(NWAVES * 64), LDS_BYTES, stream, a); }
}
```

```cpp
#include <hip/hip_runtime.h>
#include <cstdio>
#include <cstdint>


#define ONE_LAUNCH 1
#ifndef ABL
#define ABL 0
#endif
#define USE_PG8 1
#ifndef XDUP
#define XDUP 0
#endif
#ifndef UDBL
#define UDBL 0
#endif
#include <hip/hip_runtime.h>
#include <cstdio>
#include <cstdint>
namespace pg8 {
#define PG8_LAS __attribute__((address_space(3)))
typedef unsigned short bf16_t;
typedef short bf16x8 __attribute__((ext_vector_type(8)));
typedef float f32x4 __attribute__((ext_vector_type(4)));
typedef unsigned u32x4 __attribute__((ext_vector_type(4)));
typedef int i32x4 __attribute__((ext_vector_type(4)));
constexpr int BM = 256, BK = 64, HALF = 128, HTB = HALF * BK * 2  , STAGE_BYTES = 8 * HTB, NXCD = 8, WGM = 8;

__host__ __device__ __forceinline__ int lds_byte(int r, int c) { const int st = (r >> 4) * 2 + (c >> 5), rr = r & 15, cc = c & 31, ob = rr * 64 + cc * 2; return st * 1024 + (ob ^ (((ob >> 9) & 1) << 5)); }
__host__ __device__ __forceinline__ void stage_rc(int b, int& R, int& C) { const int st = b / 1024, sb = b % 1024, swz = sb ^ (((sb >> 9) & 1) << 5); R = (st >> 1) * 16 + swz / 64; C = (st & 1) * 32 + (swz % 64) / 2; }
__host__ __device__ __forceinline__ int perm32(int rho) { const int n = rho >> 4, i = rho & 15; return 8 * (i >> 2) + 4 * n + (i & 3); }

struct Unit { int pm, pn; };
struct Gemm { const bf16_t* A; const bf16_t* Bt; int M, N, K; };

struct StaticOrder {
    int nM, nN, nwg, G, c;
    __host__ __device__ __forceinline__ void init(int M, int N, int G_, int c_) { nM = M / BM; nN = N / BM; nwg = nM * nN; G = G_; c = c_; }
    __host__ __device__ __forceinline__ bool next(int i, Unit& u) const {
        const long L = (long)i * G + c; if (L >= nwg) return false;
        int wgid = (int)L; { const int q = nwg / NXCD, r = nwg % NXCD, xcd = wgid % NXCD, off = wgid / NXCD; wgid = (xcd < r ? xcd * (q + 1) : r * (q + 1) + (xcd - r) * q) + off; }
        const int nig = WGM * nN, gid = wgid / nig, fm = gid * WGM, gsz = (nM - fm) < WGM ? (nM - fm) : WGM;
        u.pm = fm + ((wgid % nig) % gsz); u.pn = (wgid % nig) / gsz; return true;
    }
    __device__ __forceinline__ void a_ready(const Unit&) const {}
    __device__ __forceinline__ void done(const Unit&) const {}
};

__device__ __forceinline__ unsigned cvt_pk_bf16(float lo, float hi) { typedef __bf16 bf2_t __attribute__((ext_vector_type(2))); typedef float f2_t __attribute__((ext_vector_type(2))); f2_t v = {lo, hi}; bf2_t b = __builtin_convertvector(v, bf2_t); return __builtin_bit_cast(unsigned, b); }
typedef float f32x2 __attribute__((ext_vector_type(2)));
typedef unsigned u32x2 __attribute__((ext_vector_type(2)));
__device__ __forceinline__ f32x2 gelu_pk(f32x2 v) {
    const f32x2 av = __builtin_elementwise_abs(v), d = av * 0.2316418882f + 1.0f;
    f32x2 t; t.x = __builtin_amdgcn_rcpf(d.x); t.y = __builtin_amdgcn_rcpf(d.y);
    f32x2 q = t * 0.5307027145f + (-0.7265760135f); q = q * t + 0.7107068705f; q = q * t + (-0.142248368f); q = q * t + 0.127414796f; q = q * t;
    const f32x2 s = (v * v) * (-0.72134752044f);
    f32x2 e; e.x = __builtin_amdgcn_exp2f(s.x); e.y = __builtin_amdgcn_exp2f(s.y);
    const f32x2 m = v * (q * e), r = v - m;
    f32x2 o; o.x = v.x < 0.f ? m.x : r.x; o.y = v.y < 0.f ? m.y : r.y; return o;
}
__device__ __forceinline__ float gelu1(float x) { f32x2 v = {x, 0.f}; return gelu_pk(v).x; }
__device__ __forceinline__ float sigmoidf_(float x) { return __builtin_amdgcn_rcpf(1.0f + __expf(-x)); }
__device__ __forceinline__ u32x4 pack8(f32x4 a, f32x4 b) { u32x4 w; w.x = cvt_pk_bf16(a[0], a[1]); w.y = cvt_pk_bf16(a[2], a[3]); w.z = cvt_pk_bf16(b[0], b[1]); w.w = cvt_pk_bf16(b[2], b[3]); return w; }
__device__ __forceinline__ u32x2 pack8u(f32x4 a, f32x4 b) { u32x2 w;
    w.x = (unsigned)__float2int_rn(a[0] * 255.f) | ((unsigned)__float2int_rn(a[1] * 255.f) << 8) | ((unsigned)__float2int_rn(a[2] * 255.f) << 16) | ((unsigned)__float2int_rn(a[3] * 255.f) << 24);
    w.y = (unsigned)__float2int_rn(b[0] * 255.f) | ((unsigned)__float2int_rn(b[1] * 255.f) << 8) | ((unsigned)__float2int_rn(b[2] * 255.f) << 16) | ((unsigned)__float2int_rn(b[3] * 255.f) << 24); return w; }
__device__ __forceinline__ unsigned short bf1(float x) { return (unsigned short)(cvt_pk_bf16(x, 0.f) & 0xffffu); }

constexpr int T_TOK = 8192, SEQ_ = 2048;
constexpr int ACT_LD = 5376, GATE_LD = 8192, MISC_LD = 64, VT_LD = 8192;

__device__ __forceinline__ void store_vt8(bf16_t* VT, int vtrow, int tok, f32x4 a, f32x4 b) {
    const unsigned o = ((unsigned)vtrow * (unsigned)VT_LD + (unsigned)tok) * 2u; unsigned char* base = (unsigned char*)VT;
#define VT_ST(k, v) *(bf16_t*)(base + (size_t)(o + (unsigned)(k) * (unsigned)VT_LD * 2u)) = bf1(v);
    VT_ST(0, a[0]) VT_ST(1, a[1]) VT_ST(2, a[2]) VT_ST(3, a[3]) VT_ST(4, b[0]) VT_ST(5, b[1]) VT_ST(6, b[2]) VT_ST(7, b[3])
#undef VT_ST
}

struct EpiWin {
    static constexpr bool PERM = true, AFTER_DRAIN = false;
    bf16_t* ACT; bf16_t* GATE; float* MISC; bf16_t* VT; const float* rope16; const float* sx; const float* sw;
    __device__ __forceinline__ f32x4 deq(const f32x4& v, float rs, const f32x4& w) const { const i32x4 q = __builtin_bit_cast(i32x4, v); return (f32x4){(float)q[0] * rs * w[0], (float)q[1] * rs * w[1], (float)q[2] * rs * w[2], (float)q[3] * rs * w[3]}; }
    __device__ __forceinline__ void operator()(const f32x4 (&acc)[2][2][4][2], const Unit& u, int wr, int wc, int fr, int fq) const {
        const int pn = u.pn; const int row0 = u.pm * BM + wr * 64 + fr; const int lc0 = wc * 32 + 8 * fq;
        const bool full_vt = (pn == 4 || pn == 5 || pn == 18 || pn == 19);
        const bool half_vt = (pn == 12 || pn == 13);
        const bool rope_t = (pn == 9 || pn == 10 || pn == 12 || pn == 13);
        const int vtbase = (pn == 4 || pn == 5) ? (pn - 4) * 256 : (pn == 18 || pn == 19) ? 512 + (pn - 18) * 256 : (pn == 12) ? 1024 - 128 : 1152 - 128;
        if (pn >= 20) {
        float rs[2][4]; f32x4 w0[2], w1[2];
#pragma unroll
        for (int ai = 0; ai < 2; ++ai)
#pragma unroll
            for (int m = 0; m < 4; ++m) rs[ai][m] = sx[row0 + ai * HALF + m * 16];
#pragma unroll
        for (int bj = 0; bj < 2; ++bj) { const float* swp = sw + pn * 256 + bj * HALF + lc0; w0[bj] = *(const f32x4*)swp; w1[bj] = *(const f32x4*)(swp + 4); }
        if (pn >= 21) {
#pragma unroll
            for (int ai = 0; ai < 2; ++ai)
#pragma unroll
                for (int m = 0; m < 4; ++m) { const int row = row0 + ai * HALF + m * 16;
#pragma unroll
                    for (int bj = 0; bj < 2; ++bj) { f32x4 a = deq(acc[ai][bj][m][0], rs[ai][m], w0[bj]), b = deq(acc[ai][bj][m][1], rs[ai][m], w1[bj]);
#pragma unroll
                        for (int i = 0; i < 4; ++i) { a[i] = sigmoidf_(a[i]); b[i] = sigmoidf_(b[i]); }
                        *(u32x2*)((unsigned char*)GATE + (size_t)((unsigned)row * (unsigned)GATE_LD + (unsigned)((pn - 21) * 256 + bj * HALF + lc0))) = pack8u(a, b); } }
            return;
        }
        if (pn == 20) {
            if (wc < 2) {
#pragma unroll
                for (int ai = 0; ai < 2; ++ai)
#pragma unroll
                    for (int m = 0; m < 4; ++m) { const int row = row0 + ai * HALF + m * 16; float* p = MISC + (size_t)row * MISC_LD + lc0;
                        *(f32x4*)p = deq(acc[ai][0][m][0], rs[ai][m], w0[0]); *(f32x4*)(p + 4) = deq(acc[ai][0][m][1], rs[ai][m], w1[0]); }
            }
            return;
        }
        }
        if (rope_t) {
            const bool do_rope = ((wc & 1) == 0) && fq < 2;
#pragma unroll
            for (int ai = 0; ai < 2; ++ai)
#pragma unroll
                for (int m = 0; m < 4; ++m) { const int row = row0 + ai * HALF + m * 16; const float rsr = sx[row];
#pragma unroll
                    for (int bj = 0; bj < 2; ++bj) { const int lc = bj * HALF + lc0; const float* swp = sw + pn * 256 + lc; f32x4 a = deq(acc[ai][bj][m][0], rsr, *(const f32x4*)swp), b = deq(acc[ai][bj][m][1], rsr, *(const f32x4*)(swp + 4));
                        if (half_vt && bj == 1) { store_vt8(VT, vtbase + lc, row, a, b); continue; }
                        if (do_rope) {
                            const f32x4* rp = (const f32x4*)(rope16 + ((size_t)(row & (SEQ_ - 1)) * 8 + 4 * fq) * 2);
                            const f32x4 c0 = rp[0], c1 = rp[1];
                            f32x4 a2, b2;
                            a2[0] = a[0] * c0[0] - a[1] * c0[1]; a2[1] = a[0] * c0[1] + a[1] * c0[0];
                            a2[2] = a[2] * c0[2] - a[3] * c0[3]; a2[3] = a[2] * c0[3] + a[3] * c0[2];
                            b2[0] = b[0] * c1[0] - b[1] * c1[1]; b2[1] = b[0] * c1[1] + b[1] * c1[0];
                            b2[2] = b[2] * c1[2] - b[3] * c1[3]; b2[3] = b[2] * c1[3] + b[3] * c1[2];
                            a = a2; b = b2;
                        }
                        *(u32x4*)((unsigned char*)ACT + (size_t)(((unsigned)row * (unsigned)ACT_LD + (unsigned)(pn * 256 + lc)) * 2u)) = pack8(a, b); } }
            return;
        }
        float rs[2][4]; f32x4 w0[2], w1[2];
#pragma unroll
        for (int ai = 0; ai < 2; ++ai)
#pragma unroll
            for (int m = 0; m < 4; ++m) rs[ai][m] = sx[row0 + ai * HALF + m * 16];
#pragma unroll
        for (int bj = 0; bj < 2; ++bj) { const float* swp = sw + pn * 256 + bj * HALF + lc0; w0[bj] = *(const f32x4*)swp; w1[bj] = *(const f32x4*)(swp + 4); }
#pragma unroll
        for (int ai = 0; ai < 2; ++ai)
#pragma unroll
            for (int m = 0; m < 4; ++m) { const int row = row0 + ai * HALF + m * 16;
#pragma unroll
                for (int bj = 0; bj < 2; ++bj) { const int lc = bj * HALF + lc0; f32x4 a = deq(acc[ai][bj][m][0], rs[ai][m], w0[bj]), b = deq(acc[ai][bj][m][1], rs[ai][m], w1[bj]);
                    if (full_vt) { store_vt8(VT, vtbase + lc, row, a, b); continue; }
                    *(u32x4*)((unsigned char*)ACT + (size_t)(((unsigned)row * (unsigned)ACT_LD + (unsigned)(pn * 256 + lc)) * 2u)) = pack8(a, b); } }
    }
};

struct EpiGate8 {
    static constexpr bool PERM = true, AFTER_DRAIN = false;
    bf16_t* GATE; const float* sx; const float* sw;
    __device__ __forceinline__ void operator()(const f32x4 (&acc)[2][2][4][2], const Unit& u, int wr, int wc, int fr, int fq) const {
        const int row0 = u.pm * BM + wr * 64 + fr; const int c00 = u.pn * BM + wc * 32 + 8 * fq;
        f32x4 w0[2], w1[2];
#pragma unroll
        for (int bj = 0; bj < 2; ++bj) { w0[bj] = *(const f32x4*)(sw + c00 + bj * HALF); w1[bj] = *(const f32x4*)(sw + c00 + bj * HALF + 4); }
#pragma unroll
        for (int ai = 0; ai < 2; ++ai)
#pragma unroll
            for (int m = 0; m < 4; ++m) { const int row = row0 + ai * HALF + m * 16; const float rs = sx[row];
#pragma unroll
                for (int bj = 0; bj < 2; ++bj) { const i32x4 ia = __builtin_bit_cast(i32x4, acc[ai][bj][m][0]), ib = __builtin_bit_cast(i32x4, acc[ai][bj][m][1]); f32x4 a, b;
#pragma unroll
                    for (int i = 0; i < 4; ++i) { a[i] = sigmoidf_((float)ia[i] * rs * w0[bj][i]); b[i] = sigmoidf_((float)ib[i] * rs * w1[bj][i]); }
                    *(u32x4*)(GATE + (size_t)row * GATE_LD + c00 + bj * HALF) = pack8(a, b); } }
    }
};

struct EpiQ8 {
    static constexpr bool PERM = true, AFTER_DRAIN = false;
    bf16_t* O; int ld; const float* sx; const float* sw;
    __device__ __forceinline__ void operator()(const f32x4 (&acc)[2][2][4][2], const Unit& u, int wr, int wc, int fr, int fq) const {
        const int row0 = u.pm * BM + wr * 64 + fr; const int c00 = u.pn * BM + wc * 32 + 8 * fq;
        f32x4 w0[2], w1[2];
#pragma unroll
        for (int bj = 0; bj < 2; ++bj) { w0[bj] = *(const f32x4*)(sw + c00 + bj * HALF); w1[bj] = *(const f32x4*)(sw + c00 + bj * HALF + 4); }
        float rsv[2][4];
#pragma unroll
        for (int ai = 0; ai < 2; ++ai)
#pragma unroll
            for (int m = 0; m < 4; ++m) rsv[ai][m] = sx[row0 + ai * HALF + m * 16];
#pragma unroll
        for (int ai = 0; ai < 2; ++ai)
#pragma unroll
            for (int m = 0; m < 4; ++m) { const int row = row0 + ai * HALF + m * 16; const float rs = rsv[ai][m];
#pragma unroll
                for (int bj = 0; bj < 2; ++bj) { const i32x4 ia = __builtin_bit_cast(i32x4, acc[ai][bj][m][0]), ib = __builtin_bit_cast(i32x4, acc[ai][bj][m][1]); f32x4 a, b;
#pragma unroll
                    for (int i = 0; i < 4; ++i) { a[i] = (float)ia[i] * rs * w0[bj][i]; b[i] = (float)ib[i] * rs * w1[bj][i]; }
                    *(u32x4*)(O + (size_t)row * ld + c00 + bj * HALF) = pack8(a, b); } }
    }
};

struct EpiGen {
    static constexpr bool PERM = true, AFTER_DRAIN = false;
    bf16_t* O; int ld, hs, act, vt_split, vt_row0, ncols, nrows; bf16_t* VT;
    __device__ __forceinline__ void operator()(const f32x4 (&acc)[2][2][4][2], const Unit& u, int wr, int wc, int fr, int fq) const {
        const int row0 = u.pm * BM + wr * 64 + fr; const int c00 = u.pn * BM + wc * 32 + 8 * fq;
#pragma unroll
        for (int ai = 0; ai < 2; ++ai)
#pragma unroll
            for (int m = 0; m < 4; ++m) { const int row = row0 + ai * HALF + m * 16; if (row >= nrows) continue;
#pragma unroll
                for (int bj = 0; bj < 2; ++bj) { f32x4 a = acc[ai][bj][m][0], b = acc[ai][bj][m][1]; const int c = c00 + bj * HALF; if (c >= ncols) continue;
                    if (c >= vt_split) { store_vt8(VT, vt_row0 + c - vt_split, row, a, b); continue; }
                    if (act == 1) { f32x2 x0 = gelu_pk((f32x2){a[0], a[1]}), x1 = gelu_pk((f32x2){a[2], a[3]}), x2 = gelu_pk((f32x2){b[0], b[1]}), x3 = gelu_pk((f32x2){b[2], b[3]});
                        a = (f32x4){x0.x, x0.y, x1.x, x1.y}; b = (f32x4){x2.x, x2.y, x3.x, x3.y}; }
                    *(u32x4*)(O + (size_t)row * ld + (c >> 6) * hs + (c & 63)) = pack8(a, b); } }
    }
};

struct EpiCmp2 {
    static constexpr bool PERM = true, AFTER_DRAIN = false;
    bf16_t* OUT; int is_k; const float* rope16;
    __device__ __forceinline__ void operator()(const f32x4 (&acc)[2][2][4][2], const Unit& u, int wr, int wc, int fr, int fq) const {
        if (wc >= 2) return;
        const int row0 = u.pm * BM + wr * 64 + fr; const int c0 = wc * 32 + 8 * fq;
#pragma unroll
        for (int ai = 0; ai < 2; ++ai)
#pragma unroll
            for (int m = 0; m < 4; ++m) { const int R = row0 + ai * HALF + m * 16; if (R >= 1016) continue;
                const int g = R & 1, bc = R >> 1, b = bc / 127, c = bc - b * 127;
                f32x4 a = acc[ai][0][m][0], bq = acc[ai][0][m][1];
                if (is_k) {
                    if (c0 < 16) { const int pos = 16 * c + 31;
                        const f32x4* rp = (const f32x4*)(rope16 + ((size_t)pos * 8 + 4 * fq) * 2); const f32x4 c0v = rp[0], c1v = rp[1]; f32x4 a2, b2;
                        a2[0] = a[0] * c0v[0] - a[1] * c0v[1]; a2[1] = a[0] * c0v[1] + a[1] * c0v[0];
                        a2[2] = a[2] * c0v[2] - a[3] * c0v[3]; a2[3] = a[2] * c0v[3] + a[3] * c0v[2];
                        b2[0] = bq[0] * c1v[0] - bq[1] * c1v[1]; b2[1] = bq[0] * c1v[1] + bq[1] * c1v[0];
                        b2[2] = bq[2] * c1v[2] - bq[3] * c1v[3]; b2[3] = bq[2] * c1v[3] + bq[3] * c1v[2];
                        a = a2; bq = b2; }
                    *(u32x4*)(OUT + ((size_t)((b * 2 + g) * 128 + c)) * 64 + c0) = pack8(a, bq);
                } else {
                    bf16_t* p = OUT + ((size_t)((b * 2 + g) * 64 + c0)) * 128 + c;
                    p[0 * 128] = bf1(a[0]); p[1 * 128] = bf1(a[1]); p[2 * 128] = bf1(a[2]); p[3 * 128] = bf1(a[3]);
                    p[4 * 128] = bf1(bq[0]); p[5 * 128] = bf1(bq[1]); p[6 * 128] = bf1(bq[2]); p[7 * 128] = bf1(bq[3]);
                } }
    }
};

struct EpiBranch {
    static constexpr bool PERM = true, AFTER_DRAIN = false;
    const bf16_t* GATE; bf16_t* ZF; bf16_t* Z;
    __device__ __forceinline__ void operator()(const f32x4 (&acc)[2][2][4][2], const Unit& u, int wr, int wc, int fr, int fq) const {
        const int n = u.pm >> 5, pm = u.pm & 31, pn = u.pn & 7;
        const int row0 = pm * BM + wr * 64 + fr; const int c00 = pn * BM + wc * 32 + 8 * fq;
        u32x2 gw[2][4][2]; u32x4 zw[4][2], res[4][2];
#define EB_RO(ai, m) ((unsigned)(row0 + (ai) * HALF + (m) * 16))
#define EB_C(bj) ((unsigned)(c00 + (bj) * HALF))
#pragma unroll
        for (int ai = 0; ai < 2; ++ai)
#pragma unroll
            for (int m = 0; m < 4; ++m)
#pragma unroll
                for (int bj = 0; bj < 2; ++bj) gw[ai][m][bj] = *(const u32x2*)((const unsigned char*)GATE + (size_t)(EB_RO(ai, m) * (unsigned)GATE_LD + (unsigned)n * 2048u + EB_C(bj)));
#pragma unroll
        for (int ai = 0; ai < 2; ++ai) {
            if (n > 0 && ai == 0) {
#pragma unroll
                for (int m = 0; m < 4; ++m)
#pragma unroll
                    for (int bj = 0; bj < 2; ++bj) zw[m][bj] = *(const u32x4*)((const unsigned char*)ZF + (size_t)((EB_RO(0, m) * 2048u + EB_C(bj)) * 2u)); }
#pragma unroll
            for (int m = 0; m < 4; ++m)
#pragma unroll
                for (int bj = 0; bj < 2; ++bj) { const u32x2 g = gw[ai][m][bj];
                    f32x4 g0, g1; constexpr float I255 = 1.0f / 255.0f;
                    g0[0] = (float)(g.x & 255u) * I255; g0[1] = (float)((g.x >> 8) & 255u) * I255; g0[2] = (float)((g.x >> 16) & 255u) * I255; g0[3] = (float)(g.x >> 24) * I255;
                    g1[0] = (float)(g.y & 255u) * I255; g1[1] = (float)((g.y >> 8) & 255u) * I255; g1[2] = (float)((g.y >> 16) & 255u) * I255; g1[3] = (float)(g.y >> 24) * I255;
                    f32x4 a = acc[ai][bj][m][0] * g0, b = acc[ai][bj][m][1] * g1;
                    if (n > 0) { const u32x4 z = zw[m][bj];
                        a[0] += __uint_as_float(z.x << 16); a[1] += __uint_as_float(z.x & 0xffff0000u); a[2] += __uint_as_float(z.y << 16); a[3] += __uint_as_float(z.y & 0xffff0000u);
                        b[0] += __uint_as_float(z.z << 16); b[1] += __uint_as_float(z.z & 0xffff0000u); b[2] += __uint_as_float(z.w << 16); b[3] += __uint_as_float(z.w & 0xffff0000u); }
                    res[m][bj] = pack8(a, b); }
            if (n > 0 && ai == 0) {
#pragma unroll
                for (int m = 0; m < 4; ++m)
#pragma unroll
                    for (int bj = 0; bj < 2; ++bj) zw[m][bj] = *(const u32x4*)((const unsigned char*)ZF + (size_t)((EB_RO(1, m) * 2048u + EB_C(bj)) * 2u)); }
#pragma unroll
            for (int m = 0; m < 4; ++m)
#pragma unroll
                for (int bj = 0; bj < 2; ++bj) *(u32x4*)((unsigned char*)(n < 3 ? ZF : Z) + (size_t)((EB_RO(ai, m) * 2048u + EB_C(bj)) * 2u)) = res[m][bj];
        }
#undef EB_RO
#undef EB_C
    }
};
struct BranchOrder {
    int G, c;
    __device__ __forceinline__ bool next(int i, Unit& u) const { const int tile = (i >> 2) * G + c; if (tile >= 256) return false; const int n = i & 3; u.pm = n * 32 + (tile >> 3); u.pn = n * 8 + (tile & 7); return true; }
    __device__ __forceinline__ void a_ready(const Unit&) const {}
    __device__ __forceinline__ void done(const Unit&) const {}
};

struct EpiPart {
    static constexpr bool PERM = false, AFTER_DRAIN = false;
    float* PART;
    __device__ __forceinline__ void operator()(const f32x4 (&acc)[2][2][4][2], const Unit& u, int wr, int wc, int fr, int fq) const {
        const int s = u.pn, pm = u.pm & 3; const int row0 = pm * BM + wr * 64 + fr; const int c00 = wc * 32 + 4 * fq; float* base = PART + (size_t)s * 1024 * 256;
#pragma unroll
        for (int ai = 0; ai < 2; ++ai)
#pragma unroll
            for (int m = 0; m < 4; ++m) { float* rp = base + (size_t)(row0 + ai * HALF + m * 16) * 256;
#pragma unroll
                for (int bj = 0; bj < 2; ++bj)
#pragma unroll
                    for (int n = 0; n < 2; ++n) *(f32x4*)(rp + c00 + bj * HALF + n * 16) = acc[ai][bj][m][n]; }
    }
};
struct SliceOrder {
    int c;
    __device__ __forceinline__ bool next(int i, Unit& u) const { if (i > 0) return false; u.pm = c; u.pn = c >> 2; return true; }
    __device__ __forceinline__ void a_ready(const Unit&) const {}
    __device__ __forceinline__ void done(const Unit&) const {}
};

struct EpiResid {
    static constexpr bool PERM = true, AFTER_DRAIN = false;
    const float* XIf; const bf16_t* XIh; bf16_t* XO;
    __device__ __forceinline__ void operator()(const f32x4 (&acc)[2][2][4][2], const Unit& u, int wr, int wc, int fr, int fq) const {
        const int row0 = u.pm * BM + wr * 64 + fr; const int c00 = u.pn * BM + wc * 32 + 8 * fq;
#define ER_O(ai, m, bj) (((unsigned)(row0 + (ai) * HALF + (m) * 16) * 2048u + (unsigned)(c00 + (bj) * HALF)))
        if (XIh) {
            u32x4 w[16];
#define ER_LD(k) w[k] = *(const u32x4*)((const unsigned char*)XIh + (size_t)(ER_O((k) >> 3, ((k) >> 1) & 3, (k) & 1) * 2u));
#define ER_ST(k) { const u32x4 x = w[k]; const f32x4 xa = {__uint_as_float(x.x << 16), __uint_as_float(x.x & 0xffff0000u), __uint_as_float(x.y << 16), __uint_as_float(x.y & 0xffff0000u)}; \
                   const f32x4 xb = {__uint_as_float(x.z << 16), __uint_as_float(x.z & 0xffff0000u), __uint_as_float(x.w << 16), __uint_as_float(x.w & 0xffff0000u)}; \
                   *(u32x4*)((unsigned char*)XO + (size_t)(ER_O((k) >> 3, ((k) >> 1) & 3, (k) & 1) * 2u)) = pack8(xa + acc[(k) >> 3][(k) & 1][((k) >> 1) & 3][0], xb + acc[(k) >> 3][(k) & 1][((k) >> 1) & 3][1]); }
            ER_LD(0) ER_LD(1) ER_LD(2) ER_LD(3) ER_LD(4) ER_LD(5) ER_LD(6) ER_LD(7) ER_LD(8) ER_LD(9) ER_LD(10) ER_LD(11)
            ER_ST(0) ER_ST(1) ER_ST(2) ER_ST(3)
            ER_LD(12) ER_LD(13) ER_LD(14) ER_LD(15)
            ER_ST(4) ER_ST(5) ER_ST(6) ER_ST(7) ER_ST(8) ER_ST(9) ER_ST(10) ER_ST(11) ER_ST(12) ER_ST(13) ER_ST(14) ER_ST(15)
#undef ER_LD
#undef ER_ST
            return;
        }
#pragma unroll
        for (int ai = 0; ai < 2; ++ai)
#pragma unroll
            for (int mh = 0; mh < 4; mh += 2) { f32x4 xa[2][2], xb[2][2];
#pragma unroll
                for (int m = 0; m < 2; ++m)
#pragma unroll
                    for (int bj = 0; bj < 2; ++bj) { const float* px = (const float*)((const unsigned char*)XIf + (size_t)(ER_O(ai, mh + m, bj) * 4u)); xa[m][bj] = *(const f32x4*)px; xb[m][bj] = *(const f32x4*)(px + 4); }
#pragma unroll
                for (int m = 0; m < 2; ++m)
#pragma unroll
                    for (int bj = 0; bj < 2; ++bj) *(u32x4*)((unsigned char*)XO + (size_t)(ER_O(ai, mh + m, bj) * 2u)) = pack8(xa[m][bj] + acc[ai][bj][mh + m][0], xb[m][bj] + acc[ai][bj][mh + m][1]); }
#undef ER_O
    }
};
template <class Epi, class Sched, bool ALIGN_EPI = false, bool SP2 = false, bool I8 = false>
__device__ __forceinline__ void gemm_phase(PG8_LAS unsigned char* lds, const Gemm g, const Sched& S, const Epi& E) {
    int tid_ = threadIdx.x; asm volatile("" : "+v"(tid_));
    const int tid = tid_, wid = __builtin_amdgcn_readfirstlane(tid >> 6), lane = tid & 63, wr = wid >> 2, wc = wid & 3, fr = lane & 15, fq = lane >> 4;
    const int K = g.K, nt = K / BK;
    unsigned voffA[2], voffB[2];
#pragma unroll
    for (int i = 0; i < 2; ++i) { int R, C; stage_rc(tid * 16 + i * 8192, R, C); const int Rb = Epi::PERM ? ((R & ~31) + perm32(R & 31)) : R;
        voffA[i] = (unsigned)(R * K + C) * 2u; voffB[i] = (unsigned)(Rb * K + C) * 2u; }
    const size_t kstep = (size_t)(BK * 2);
    const size_t hstep = (size_t)HALF * K * 2;
    const size_t tstep = 2 * hstep;
    const unsigned ldsw = (unsigned)wid * 1024u;
    const int aoff = lds_byte(wr * 64 + fr, fq * 8), boff = lds_byte(wc * 32 + fr, fq * 8);
#define PG8_SA(b, h) (((b) * 2 + (h)) * HTB)
#define PG8_SB(b, h) ((4 + (b) * 2 + (h)) * HTB)
#define PG8_STAGE(bufoff, gbase, voff) do { _Pragma("unroll") for (int _i = 0; _i < 2; ++_i) \
        __builtin_amdgcn_global_load_lds((const unsigned*)((const char*)(gbase) + (voff)[_i]), (PG8_LAS unsigned*)(lds + (bufoff) + ldsw + _i * 8192), 16, 0, 0); } while (0)
#define PG8_LDA(dst, b, h) do { _Pragma("unroll") for (int m = 0; m < 4; ++m) _Pragma("unroll") for (int k = 0; k < 2; ++k) dst[m][k] = *(const PG8_LAS bf16x8*)(lds + PG8_SA(b, h) + aoff + m * 2048 + k * 1024); } while (0)
#define PG8_LDB(dst, b, h) do { _Pragma("unroll") for (int n = 0; n < 2; ++n) _Pragma("unroll") for (int k = 0; k < 2; ++k) dst[n][k] = *(const PG8_LAS bf16x8*)(lds + PG8_SB(b, h) + boff + n * 2048 + k * 1024); } while (0)
#define PG8_MMA(ai, bj, At, Bt) do { __builtin_amdgcn_s_setprio(1); _Pragma("unroll") for (int m = 0; m < 4; ++m) _Pragma("unroll") for (int n = 0; n < 2; ++n) _Pragma("unroll") for (int k = 0; k < 2; ++k) \
        { if constexpr (I8) acc[ai][bj][m][n] = __builtin_bit_cast(f32x4, __builtin_amdgcn_mfma_i32_16x16x64_i8(__builtin_bit_cast(i32x4, Bt[n][k]), __builtin_bit_cast(i32x4, At[m][k]), __builtin_bit_cast(i32x4, acc[ai][bj][m][n]), 0, 0, 0)); \
          else acc[ai][bj][m][n] = __builtin_amdgcn_mfma_f32_16x16x32_bf16(Bt[n][k], At[m][k], acc[ai][bj][m][n], 0, 0, 0); } __builtin_amdgcn_s_setprio(0); } while (0)
#ifdef PG8_DRAIN_ALL
#define PG8_WAIT_V(n) asm volatile("s_waitcnt vmcnt(0)" ::: "memory")
#else
#define PG8_WAIT_V(n) asm volatile("s_waitcnt vmcnt(" #n ")" ::: "memory")
#endif
#define PG8_WAIT_L(n) asm volatile("s_waitcnt lgkmcnt(" #n ")" ::: "memory")
#define PG8_BAR __builtin_amdgcn_s_barrier()
#define PG8_SCHED __builtin_amdgcn_sched_barrier(0)
    Unit cur, nxt; int ui = 0;
    if (!S.next(0, cur)) return;
    f32x4 acc[2][2][4][2];
#pragma unroll
    for (int a = 0; a < 2; ++a)
#pragma unroll
        for (int b = 0; b < 2; ++b)
#pragma unroll
            for (int m = 0; m < 4; ++m)
#pragma unroll
                for (int n = 0; n < 2; ++n) acc[a][b][m][n] = (f32x4){0.f, 0.f, 0.f, 0.f};
    bf16x8 At[4][2], B0[2][2], B1[2][2];
    const char* cA = (const char*)g.A + (size_t)cur.pm * tstep; const char* cB = (const char*)g.Bt + (size_t)cur.pn * tstep;
    S.a_ready(cur);
    if constexpr (SP2) {
        PG8_STAGE(PG8_SB(0, 0), cB, voffB); PG8_STAGE(PG8_SB(0, 1), cB + hstep, voffB); PG8_STAGE(PG8_SA(0, 0), cA, voffA); PG8_STAGE(PG8_SA(0, 1), cA + hstep, voffA);
        if (wr == 1) PG8_BAR;
        PG8_WAIT_V(2); PG8_BAR;
        PG8_STAGE(PG8_SB(1, 0), cB + kstep, voffB); PG8_STAGE(PG8_SA(1, 0), cA + kstep, voffA); PG8_STAGE(PG8_SB(1, 1), cB + hstep + kstep, voffB);
        PG8_WAIT_V(6); PG8_BAR;
    } else {
        PG8_STAGE(PG8_SB(0, 0), cB, voffB); PG8_STAGE(PG8_SA(0, 0), cA, voffA); PG8_STAGE(PG8_SB(0, 1), cB + hstep, voffB); PG8_STAGE(PG8_SA(0, 1), cA + hstep, voffA);
        if (wr == 1) PG8_BAR;
        PG8_WAIT_V(4); PG8_BAR;
        PG8_STAGE(PG8_SB(1, 0), cB + kstep, voffB); PG8_STAGE(PG8_SA(1, 0), cA + kstep, voffA); PG8_STAGE(PG8_SB(1, 1), cB + hstep + kstep, voffB);
        PG8_WAIT_V(6); PG8_BAR;
    }
    for (;;) {
        const bool has_next = S.next(ui + 1, nxt);
        const char* nA = has_next ? (const char*)g.A + (size_t)nxt.pm * tstep : cA; const char* nB = has_next ? (const char*)g.Bt + (size_t)nxt.pn * tstep : cB;
        for (int t = 0; t < nt; t += 2) {
            const bool last = (t == nt - 2);
            const char* a1 = cA + (size_t)(t + 1) * kstep;
            const char* a2 = last ? nA : cA + (size_t)(t + 2) * kstep; const char* b2 = last ? nB : cB + (size_t)(t + 2) * kstep;
            const char* a3 = a2 + kstep; const char* b3 = b2 + kstep;
            if (last && has_next) S.a_ready(nxt);
            if constexpr (SP2) {
            PG8_LDB(B0, 0, 0); PG8_LDB(B1, 0, 1); PG8_SCHED; PG8_LDA(At, 0, 0); PG8_STAGE(PG8_SA(1, 1), a1 + hstep, voffA);
            PG8_WAIT_V(8); PG8_WAIT_L(0); PG8_BAR; PG8_MMA(0, 0, At, B0); PG8_MMA(0, 1, At, B1); PG8_BAR; PG8_SCHED;
            PG8_LDA(At, 0, 1); PG8_STAGE(PG8_SB(0, 0), b2, voffB); PG8_STAGE(PG8_SB(0, 1), b2 + hstep, voffB); PG8_STAGE(PG8_SA(0, 0), a2, voffA);
            PG8_WAIT_V(8); PG8_WAIT_L(0); PG8_BAR; PG8_MMA(1, 0, At, B0); PG8_MMA(1, 1, At, B1); PG8_BAR; PG8_SCHED;
            PG8_LDB(B0, 1, 0); PG8_LDB(B1, 1, 1); PG8_SCHED; PG8_LDA(At, 1, 0); PG8_STAGE(PG8_SA(0, 1), a2 + hstep, voffA);
            PG8_WAIT_V(8); PG8_WAIT_L(0); PG8_BAR; PG8_MMA(0, 0, At, B0); PG8_MMA(0, 1, At, B1); PG8_BAR; PG8_SCHED;
            PG8_LDA(At, 1, 1); PG8_STAGE(PG8_SB(1, 0), b3, voffB); PG8_STAGE(PG8_SB(1, 1), b3 + hstep, voffB); PG8_STAGE(PG8_SA(1, 0), a3, voffA);
            PG8_WAIT_V(8); PG8_WAIT_L(0); PG8_BAR; PG8_MMA(1, 0, At, B0); PG8_MMA(1, 1, At, B1); PG8_BAR; PG8_SCHED;
            } else {
            PG8_LDB(B0, 0, 0); PG8_SCHED; PG8_LDA(At, 0, 0); PG8_STAGE(PG8_SA(1, 1), a1 + hstep, voffA);
            PG8_WAIT_L(8); PG8_BAR; PG8_WAIT_L(0); PG8_MMA(0, 0, At, B0); PG8_BAR; PG8_SCHED;
            PG8_LDB(B1, 0, 1); PG8_STAGE(PG8_SB(0, 0), b2, voffB);
            PG8_BAR; PG8_WAIT_L(0); PG8_MMA(0, 1, At, B1); PG8_BAR;
            PG8_LDA(At, 0, 1); PG8_STAGE(PG8_SA(0, 0), a2, voffA);
            PG8_BAR; PG8_WAIT_L(0); PG8_MMA(1, 0, At, B0); PG8_BAR; PG8_SCHED;
            PG8_STAGE(PG8_SB(0, 1), b2 + hstep, voffB);
            PG8_WAIT_V(6); PG8_BAR; PG8_MMA(1, 1, At, B1); PG8_BAR;
            PG8_LDB(B0, 1, 0); PG8_SCHED; PG8_LDA(At, 1, 0); PG8_STAGE(PG8_SA(0, 1), a2 + hstep, voffA);
            PG8_WAIT_L(8); PG8_BAR; PG8_WAIT_L(0); PG8_MMA(0, 0, At, B0); PG8_BAR; PG8_SCHED;
            PG8_LDB(B1, 1, 1); PG8_STAGE(PG8_SB(1, 0), b3, voffB);
            PG8_BAR; PG8_WAIT_L(0); PG8_MMA(0, 1, At, B1); PG8_BAR;
            PG8_LDA(At, 1, 1); PG8_STAGE(PG8_SA(1, 0), a3, voffA);
            PG8_BAR; PG8_WAIT_L(0); PG8_MMA(1, 0, At, B0); PG8_BAR; PG8_SCHED;
            PG8_STAGE(PG8_SB(1, 1), b3 + hstep, voffB);
            PG8_WAIT_V(6); PG8_BAR; PG8_MMA(1, 1, At, B1); PG8_BAR;
            }
        }
        if constexpr (ALIGN_EPI) { if (wr == 0) PG8_BAR; }
        if constexpr (!Epi::AFTER_DRAIN) { E(acc, cur, wr, wc, fr, fq); asm volatile("s_waitcnt vmcnt(0)" ::: "memory"); S.done(cur); }
        if (!has_next) break;
#pragma unroll
        for (int a = 0; a < 2; ++a)
#pragma unroll
            for (int b = 0; b < 2; ++b)
#pragma unroll
                for (int m = 0; m < 4; ++m)
#pragma unroll
                    for (int n = 0; n < 2; ++n) acc[a][b][m][n] = (f32x4){0.f, 0.f, 0.f, 0.f};
        cur = nxt; cA = nA; cB = nB; ++ui;
        if constexpr (ALIGN_EPI) { if (wr == 1) PG8_BAR; }
    }
    PG8_WAIT_V(0);
    if constexpr (!ALIGN_EPI) { if (wr == 0) PG8_BAR; }
    PG8_BAR;
    if constexpr (Epi::AFTER_DRAIN) { E.fused(acc, cur, wr, wc, fr, fq, lds, wid, lane); S.done(cur); }
#undef PG8_SA
#undef PG8_SB
#undef PG8_STAGE
#undef PG8_LDA
#undef PG8_LDB
#undef PG8_MMA
#undef PG8_WAIT_V
#undef PG8_WAIT_L
#undef PG8_BAR
#undef PG8_SCHED
}
}
namespace pg8 {
template <class Epi, class Sched>
__device__ __forceinline__ void gemm_simple(PG8_LAS unsigned char* lds, const Gemm g, const Sched& S, const Epi& E) {
    int tid_ = threadIdx.x; asm volatile("" : "+v"(tid_));
    const int tid = tid_, wid = __builtin_amdgcn_readfirstlane(tid >> 6), lane = tid & 63, wr = wid >> 2, wc = wid & 3, fr = lane & 15, fq = lane >> 4;
    const int K = g.K, nt = K / BK; constexpr int LSTR = 144;
    PG8_LAS unsigned char* As = lds; PG8_LAS unsigned char* Bs = lds + 256 * LSTR;
    const int srow = tid >> 3, sch = tid & 7;
    const int aoff = (wr * 64 + fr) * LSTR + fq * 16;
    int boff[2];
#pragma unroll
    for (int n = 0; n < 2; ++n) boff[n] = (wc * 32 + (Epi::PERM ? perm32(16 * n + fr) : 16 * n + fr)) * LSTR + fq * 16;
    Unit cur;
    for (int ui = 0; S.next(ui, cur); ++ui) {
        const bf16_t* Ag = g.A + (size_t)cur.pm * BM * K + (size_t)srow * K + sch * 8; const bf16_t* Bg = g.Bt + (size_t)cur.pn * BM * K + (size_t)srow * K + sch * 8;
        f32x4 acc[2][2][4][2];
#pragma unroll
        for (int a = 0; a < 2; ++a)
#pragma unroll
            for (int b = 0; b < 2; ++b)
#pragma unroll
                for (int m = 0; m < 4; ++m)
#pragma unroll
                    for (int n = 0; n < 2; ++n) acc[a][b][m][n] = (f32x4){0.f, 0.f, 0.f, 0.f};
        u32x4 ra[4], rb[4];
#pragma unroll
        for (int i = 0; i < 4; ++i) { ra[i] = *(const u32x4*)(Ag + (size_t)(64 * i) * K); rb[i] = *(const u32x4*)(Bg + (size_t)(64 * i) * K); }
        for (int t = 0; t < nt; ++t) {
            __syncthreads();
#pragma unroll
            for (int i = 0; i < 4; ++i) { *(PG8_LAS u32x4*)(As + (srow + 64 * i) * LSTR + sch * 16) = ra[i]; *(PG8_LAS u32x4*)(Bs + (srow + 64 * i) * LSTR + sch * 16) = rb[i]; }
            if (t + 1 < nt) {
#pragma unroll
                for (int i = 0; i < 4; ++i) { ra[i] = *(const u32x4*)(Ag + (size_t)(64 * i) * K + (t + 1) * BK); rb[i] = *(const u32x4*)(Bg + (size_t)(64 * i) * K + (t + 1) * BK); } }
            __syncthreads();
#pragma unroll
            for (int ai = 0; ai < 2; ++ai) {
                bf16x8 At[4][2];
#pragma unroll
                for (int m = 0; m < 4; ++m)
#pragma unroll
                    for (int k = 0; k < 2; ++k) At[m][k] = *(const PG8_LAS bf16x8*)(As + aoff + (ai * HALF + m * 16) * LSTR + k * 64);
#pragma unroll
                for (int bj = 0; bj < 2; ++bj) {
                    bf16x8 Bt[2][2];
#pragma unroll
                    for (int n = 0; n < 2; ++n)
#pragma unroll
                        for (int k = 0; k < 2; ++k) Bt[n][k] = *(const PG8_LAS bf16x8*)(Bs + boff[n] + bj * HALF * LSTR + k * 64);
#pragma unroll
                    for (int m = 0; m < 4; ++m)
#pragma unroll
                        for (int n = 0; n < 2; ++n)
#pragma unroll
                            for (int k = 0; k < 2; ++k) acc[ai][bj][m][n] = __builtin_amdgcn_mfma_f32_16x16x32_bf16(Bt[n][k], At[m][k], acc[ai][bj][m][n], 0, 0, 0);
                }
            }
        }
        E(acc, cur, wr, wc, fr, fq);
    }
    __syncthreads();
}
}
using pg8::ACT_LD; using pg8::GATE_LD; using pg8::MISC_LD; using pg8::VT_LD; using pg8::sigmoidf_;
#define GAS __attribute__((address_space(1)))
#define LAS __attribute__((address_space(3)))
typedef unsigned short bf16;
typedef unsigned v4u __attribute__((ext_vector_type(4)));
typedef unsigned v2u __attribute__((ext_vector_type(2)));
typedef float f32x4 __attribute__((ext_vector_type(4)));
typedef float f32x2 __attribute__((ext_vector_type(2)));
typedef float f32x16 __attribute__((ext_vector_type(16)));
typedef short bf16x8 __attribute__((ext_vector_type(8)));
typedef short s16x4 __attribute__((ext_vector_type(4)));
typedef GAS unsigned gu32;
typedef GAS unsigned long long gu64;
#define RLX_AGENT __ATOMIC_RELAXED, __HIP_MEMORY_SCOPE_AGENT
#define LDS_WAIT() asm volatile("s_waitcnt lgkmcnt(0)" ::: "memory")
#define VM_WAIT() asm volatile("s_waitcnt vmcnt(0)" ::: "memory")
__device__ __forceinline__ unsigned f2bf(float f) { unsigned u = __builtin_bit_cast(unsigned, f); return (u + 0x7fffu + ((u >> 16) & 1u)) >> 16; }
__device__ __forceinline__ unsigned pk2(float lo, float hi) { return f2bf(lo) | (f2bf(hi) << 16); }
__device__ __forceinline__ float bflo(unsigned w) { return __uint_as_float(w << 16); }
__device__ __forceinline__ float bfhi(unsigned w) { return __uint_as_float(w & 0xffff0000u); }
__device__ __forceinline__ float bf2f(bf16 h) { return __uint_as_float(((unsigned)h) << 16); }

#define XB_TMO      128
#define XB_XCNT(j)  (256  + 64 * (j))
#define XB_XSUB(j)  (1280 + 64 * (j))
#define XB_XGEN(j)  (2304 + 64 * (j))
#define XB_TOP      3328
#define XB_TOPGEN   3392
#define XCD_BAR_WORDS 3456
#define XB_SPIN_CAP (1u << 18)

__device__ __forceinline__ unsigned xb_ld(unsigned* p)              { return __hip_atomic_load(p, __ATOMIC_RELAXED, __HIP_MEMORY_SCOPE_AGENT); }
__device__ __forceinline__ unsigned xb_add(unsigned* p, unsigned v) { return __hip_atomic_fetch_add(p, v, __ATOMIC_RELAXED, __HIP_MEMORY_SCOPE_AGENT); }
__device__ __forceinline__ unsigned xb_xcc_id() { return (unsigned)__builtin_amdgcn_s_getreg((3 << 11) | 20) & 0xFu; }
#define XB_SPIN(cond, bar) do { unsigned _sp = 0; while (cond) { __builtin_amdgcn_s_sleep(1); \
    if ((++_sp & 255u) == 0u) { if (xb_ld(&(bar)[XB_TMO])) break; if (_sp > XB_SPIN_CAP) { atomicAdd(&(bar)[XB_TMO], 1u); break; } } } } while (0)

struct XcdBarrier {
    unsigned* bar; unsigned x;
    volatile LAS unsigned* st;
};

__device__ __forceinline__ XcdBarrier xcd_barrier_post(unsigned* bar, volatile LAS unsigned* st) {
    XcdBarrier b; b.bar = bar; b.x = xb_xcc_id(); b.st = st;
    if (threadIdx.x == 0) (void)xb_add(&bar[XB_XCNT(b.x)], 1u);
    return b;
}
__device__ __forceinline__ void xcd_barrier_complete(unsigned* bar, unsigned x, unsigned& nloc, unsigned& nx) {
    const unsigned G = gridDim.x * gridDim.y * gridDim.z;
    unsigned sum, cnt, mine, sp = 0u;
    for (;;) {
        sum = 0u; cnt = 0u; mine = 0u;
#pragma unroll
        for (unsigned j = 0; j < 16; ++j) { const unsigned c = xb_ld(&bar[XB_XCNT(j)]); sum += c; cnt += (c > 0u) ? 1u : 0u; mine = (j == x) ? c : mine; }
        if (sum == G) break;
        __builtin_amdgcn_s_sleep(1);
        if ((++sp & 255u) == 0u) { if (xb_ld(&bar[XB_TMO])) break; if (sp > XB_SPIN_CAP) { atomicAdd(&bar[XB_TMO], 1u); break; } }
    }
    nloc = mine > 0u ? mine : 1u; nx = cnt > 0u ? cnt : 1u;
}

__device__ __forceinline__ void xcd_barrier(const XcdBarrier& b) {
    asm volatile("s_waitcnt vmcnt(0)" ::: "memory");
    __syncthreads();
    if (threadIdx.x == 0) {
        unsigned* bar = b.bar;
        __builtin_amdgcn_s_waitcnt(0);
        unsigned nloc = b.st[0], nx = b.st[1];
        if (nloc == 0u) { xcd_barrier_complete(bar, b.x, nloc, nx); b.st[0] = nloc; b.st[1] = nx; }
        const unsigned old = xb_add(&bar[XB_XSUB(b.x)], 1u);
        const unsigned gen = old / nloc;
        if (old + 1u == (gen + 1u) * nloc) {
            __builtin_amdgcn_fence(__ATOMIC_RELEASE, "agent");
            asm volatile("s_waitcnt vmcnt(0)" ::: "memory");
            const unsigned og = xb_add(&bar[XB_TOP], 1u);
            const unsigned tg = og / nx;
            if (og + 1u == (tg + 1u) * nx) xb_add(&bar[XB_TOPGEN], 1u);
            else XB_SPIN(xb_ld(&bar[XB_TOPGEN]) == tg, bar);
            __builtin_amdgcn_fence(__ATOMIC_ACQUIRE, "agent");
            xb_add(&bar[XB_XGEN(b.x)], 1u);
            asm volatile("s_waitcnt vmcnt(0)" ::: "memory");
        } else {
            XB_SPIN(xb_ld(&bar[XB_XGEN(b.x)]) == gen, bar);
            __builtin_amdgcn_fence(__ATOMIC_ACQUIRE, "agent");
            asm volatile("s_waitcnt vmcnt(0)" ::: "memory");
        }
    }
    __syncthreads();
}
constexpr int NWAVES = 8, NTHR = 512;
constexpr int NB = 4, SEQ = 2048, NTOK = 8192, DM = 2048, NHEAD = 8, HDIM = 64, NLAYER = 2;
constexpr int NWIN = 13568, NWIN_SRC = 13376;
constexpr float RMS_EPS = 1e-6f, LOG2E = 1.4426950408889634f;
constexpr int C_FQ = 0, C_FK = 512, C_MCQ = 1536, C_MCKV = 2048, C_NQ = 2304, C_NKC = 2816, C_NVC = 2944, C_NKS = 3072, C_NKW = 3328, C_SQ = 3584, C_SK = 4096;
constexpr int R_FV = 0, R_SV = 512, R_NVS = 1024, R_NVW = 1152, R_MV = 1280, VT_ROWS = 1792;

constexpr size_t MiB = 1u << 20;
constexpr size_t WS_CTL = 0, CTL_ZERO_BYTES = 1 * MiB;
constexpr size_t LW_WIN = 0;
constexpr size_t LW_WUQ = LW_WIN + (size_t)NWIN * 2048;
constexpr size_t LW_WUKV = LW_WUQ + (size_t)768 * 512 * 2;
constexpr size_t LW_KCW1 = LW_WUKV + (size_t)1024 * 256 * 2;
constexpr size_t LW_VCW1 = LW_KCW1 + (size_t)256 * 2048 * 2;
constexpr size_t LW_KCW2 = LW_VCW1 + (size_t)256 * 2048 * 2;
constexpr size_t LW_VCW2 = LW_KCW2 + (size_t)256 * 256 * 2;
constexpr size_t LW_WBR = LW_VCW2 + (size_t)256 * 256 * 2;
constexpr size_t LW_WOUT = LW_WBR + (size_t)8192 * 512 * 2;
constexpr size_t LW_WQ = LW_WOUT + (size_t)2048 * 2048 * 2;
constexpr size_t LW_SK1 = LW_WQ + (size_t)2048 * 2048 * 2;
constexpr size_t LW_SK2 = LW_SK1 + (size_t)8 * 128 * 128 * 2;
constexpr size_t LW_U = LW_SK2 + (size_t)8 * 128 * 128 * 2;
constexpr size_t LW_V = LW_U + (size_t)16384 * 2048;
constexpr size_t LW_SU = LW_V + (size_t)16384 * 2048;
constexpr size_t LW_SV = LW_SU + (size_t)16384 * 4;
constexpr size_t LW_SWIN = LW_SV + (size_t)16384 * 4;
constexpr size_t LW_SWQ = LW_SWIN + (size_t)NWIN * 4;
constexpr size_t LW_WQB = LW_SWQ + (size_t)2048 * 4;
constexpr size_t LW_BYTES = LW_WQB + (size_t)2048 * 2048 * 2;
constexpr size_t WS_W = 1 * MiB;
constexpr size_t WS_A0 = WS_W + NLAYER * LW_BYTES;
constexpr size_t WS_HN = WS_A0;
constexpr size_t WS_ACT = WS_HN + (size_t)NTOK * 2048 * 2;
constexpr size_t WS_ZF = WS_ACT;
constexpr size_t WS_GATE = WS_ACT + (size_t)NTOK * 5376 * 2;
constexpr size_t WS_MISC = WS_GATE + (size_t)NTOK * 8192 * 2;
constexpr size_t WS_VT = WS_MISC + (size_t)NTOK * 64 * 4;
constexpr size_t WS_EIDX = WS_VT, WS_EGATE = WS_VT + (size_t)NTOK * 128 * 4;
constexpr size_t WS_FCUM = WS_VT + (size_t)VT_ROWS * NTOK * 2;
constexpr size_t WS_CQN = WS_FCUM + (size_t)32 * 2048 * 4 + 256;
constexpr size_t WS_CKVN = WS_CQN + (size_t)NTOK * 512 * 2;
constexpr size_t WS_QM = WS_CKVN + (size_t)NTOK * 256 * 2;
constexpr size_t WS_KM = WS_QM + (size_t)NTOK * 768 * 2;
constexpr size_t WS_ABK = WS_KM + (size_t)NTOK * 768 * 2;
constexpr size_t WS_ABV = WS_ABK + (size_t)1024 * 2048 * 2;
constexpr size_t WS_HK = WS_ABV + (size_t)1024 * 2048 * 2;
constexpr size_t WS_HV = WS_HK + (size_t)1024 * 256 * 2;
constexpr size_t WS_KC = WS_HV + (size_t)1024 * 256 * 2;
constexpr size_t WS_VCT = WS_KC + (size_t)8 * 128 * 64 * 2;
constexpr size_t WS_BR = WS_VCT + (size_t)8 * 64 * 128 * 2;
constexpr size_t WS_QP = WS_BR;
constexpr size_t WS_Z = WS_BR + (size_t)4 * NTOK * 512 * 2;
constexpr size_t WS_XA = WS_Z + (size_t)NTOK * 2048 * 2;
constexpr size_t WS_XB = WS_XA + (size_t)NTOK * 2048 * 4;
constexpr size_t WS_R16 = WS_XB + (size_t)NTOK * 2048 * 4;
constexpr size_t WS_R32 = WS_R16 + (size_t)2048 * 8 * 2 * 4;
constexpr size_t WS_HN8 = WS_R32 + (size_t)2048 * 16 * 2 * 4;
constexpr size_t WS_SXH = WS_HN8 + (size_t)NTOK * 2048;
constexpr size_t WS_END = WS_SXH + (size_t)NTOK * 4;
static_assert(WS_END <= (size_t)1024 * MiB, "workspace map must fit 1 GiB");
static_assert((size_t)NTOK * 2048 * 4 <= (size_t)NTOK * 5376 * 2, "ZF overlay");
constexpr int CW_TMO = 0, CW_BAR = 4096, CW_COLMAX = 65536, CM_LAYER = 13568 + 2048, CW_FOXN = 131072, CW_NSAF = 139264;

constexpr int RING_OFF = 0, RING_BYTES = 131072;
constexpr int LDSCTL_OFF = RING_BYTES, MISC_OFF = LDSCTL_OFF + 320;
constexpr int LDS_BYTES = 147456;
struct Frame {
    LAS unsigned char* lds;
    volatile LAS unsigned* MISCW;
    gu32* ctl;
    int tid, lane, wave, vcu, G;
    unsigned char* ws;
    float* out;
};
__device__ __forceinline__ float wave_sum(float v) {
#pragma unroll
    for (int o = 1; o < 64; o <<= 1) v += __shfl_xor(v, o);
    return v;
}
__device__ __forceinline__ int win_src_col(int d) {
    if (d < 1536) return d;
    if (d < 2304) return 1544 + (d - 1536);
    if (d < 3584) { const int o = d - 2304; int src = 2344 + o;
        const bool il = (o < 512) || (o >= 768 && o < 896) || (o >= 1024 && o < 1152);
        if (il) { const int hl = o & 63; if (hl < 16) src = 2344 + (o & ~63) + (hl >> 1) + 8 * (hl & 1); }
        return src; }
    if (d < 5120) return 3648 + (d - 3584);
    if (d < 5128) return 1536 + (d - 5120);
    if (d < 5160) return 2312 + (d - 5128);
    if (d < 5184) return 3624 + (d - 5160);
    if (d < 5376) return -1;
    return 5184 + (d - 5376);
}
__device__ __forceinline__ int map_col(int map, int n, int Nsrc) {
    if (map == 1) return win_src_col(n);
    if (map == 2) { const int hh = (n & 511) >> 6, d = n & 63; return hh * 128 + (n >= 512 ? 64 : 0) + d; }
    if (map == 3) { if (n >= 64) return -1; return n < 16 ? (n >> 1) + 8 * (n & 1) : n; }
    return n < Nsrc ? n : -1;
}
struct TrSrc { const float* W; int K, Nsrc; bf16* WT; int Ndst, map, sliced, item; };
__device__ __forceinline__ int tr_load(const TrSrc& t, int lane, float (&tv)[32]) {
    const int nblk = t.Ndst / 32, kb = t.item / nblk, nb = t.item % nblk, k0 = 64 * kb, n0 = 32 * nb;
    const int sc = map_col(t.map, n0 + (lane & 31), t.Nsrc); const float* wp = t.W + (size_t)(k0 + (lane >> 5)) * t.Nsrc + (sc >= 0 ? sc : 0);
#pragma unroll
    for (int i = 0; i < 32; ++i) tv[i] = wp[(size_t)(2 * i) * t.Nsrc];
    return sc;
}
__device__ __forceinline__ void tr_finish(const TrSrc& t, int sc, const float (&tv)[32], LAS float* scr, int lane) {
    const int nblk = t.Ndst / 32, kb = t.item / nblk, nb = t.item % nblk, k0 = 64 * kb, n0 = 32 * nb;
#pragma unroll
    for (int i = 0; i < 32; ++i) { const int kk = 2 * i + (lane >> 5); scr[kk * 33 + (lane & 31)] = (sc >= 0) ? tv[i] : 0.f; }
    LDS_WAIT(); asm volatile("" ::: "memory");
    const int c = lane & 7;
#pragma unroll
    for (int j = 0; j < 4; ++j) { const int n = (lane >> 3) + 8 * j; const LAS float* s = scr + (8 * c) * 33 + n;
        v4u o; o.x = pk2(s[0 * 33], s[1 * 33]); o.y = pk2(s[2 * 33], s[3 * 33]); o.z = pk2(s[4 * 33], s[5 * 33]); o.w = pk2(s[6 * 33], s[7 * 33]);
        bf16* dp = t.sliced ? t.WT + (size_t)(k0 >> 9) * t.Ndst * 512 + (size_t)(n0 + n) * 512 + (k0 & 511) + 8 * c : t.WT + (size_t)(n0 + n) * t.K + k0 + 8 * c;
        *(GAS v4u*)dp = o; }
    LDS_WAIT(); asm volatile("" ::: "memory");
}
__device__ __forceinline__ void rms_row_to_bf16(int lane, const float* xrow, const float* gain, bf16* orow, signed char* o8 = nullptr, float* sx = nullptr) {
    f32x4 v[8]; float s = 0.f;
#pragma unroll
    for (int j = 0; j < 8; ++j) { v[j] = *((const f32x4*)xrow + lane + 64 * j); s += (v[j].x * v[j].x + v[j].y * v[j].y) + (v[j].z * v[j].z + v[j].w * v[j].w); }
    const float rstd = 1.0f / sqrtf(wave_sum(s) * (1.f / 2048.f) + RMS_EPS); float am = 0.f;
    f32x4 g[8];
#pragma unroll
    for (int j = 0; j < 8; ++j) g[j] = *((const f32x4*)gain + lane + 64 * j);
#pragma unroll
    for (int j = 0; j < 8; ++j) { v[j] = v[j] * rstd * g[j];
        v2u o; o.x = pk2(v[j].x, v[j].y); o.y = pk2(v[j].z, v[j].w);
        *((v2u*)orow + lane + 64 * j) = o; am = fmaxf(am, fmaxf(fmaxf(fabsf(v[j].x), fabsf(v[j].y)), fmaxf(fabsf(v[j].z), fabsf(v[j].w)))); }
    if (o8) {
#pragma unroll
        for (int o = 1; o < 64; o <<= 1) am = fmaxf(am, __shfl_xor(am, o));
        am = fmaxf(am, 1e-30f); const float sc = 127.0f / am;
#pragma unroll
        for (int j = 0; j < 8; ++j) { const int q0 = __float2int_rn(v[j].x * sc), q1 = __float2int_rn(v[j].y * sc), q2 = __float2int_rn(v[j].z * sc), q3 = __float2int_rn(v[j].w * sc);
            *((unsigned*)o8 + lane + 64 * j) = (unsigned)(q0 & 255) | ((unsigned)(q1 & 255) << 8) | ((unsigned)(q2 & 255) << 16) | ((unsigned)(q3 & 255) << 24); }
        if (lane == 0) *sx = am * (1.0f / 127.0f); }
}
__device__ __forceinline__ int win_dst_row(int s) {
    if (s < 1536) return s;
    if (s < 1544) return 5120 + (s - 1536);
    if (s < 2312) return 1536 + (s - 1544);
    if (s < 2344) return 5128 + (s - 2312);
    if (s < 3624) { const int o = s - 2344; const bool il = (o < 512) || (o >= 768 && o < 896) || (o >= 1024 && o < 1152); const int hl = o & 63;
        if (il && hl < 16) return 2304 + (o & ~63) + 2 * (hl & 7) + (hl >> 3);
        return 2304 + o; }
    if (s < 3648) return 5160 + (s - 3624);
    if (s < 5184) return 3584 + (s - 3648);
    return 5376 + (s - 5184);
}
struct Q8Src { const float* W; int Nsrc, map, item; signed char* WT; float* sw; };
__device__ __forceinline__ void q8_load(const Q8Src& q, int tid, f32x4 (&v)[8][4]) {
    const int cg = tid & 7, rl = tid >> 3; const float* wp = q.W + (size_t)(4 * rl) * q.Nsrc + 32 * q.item + 4 * cg;
#pragma unroll
    for (int j = 0; j < 8; ++j)
#pragma unroll
        for (int r = 0; r < 4; ++r) v[j][r] = *(const f32x4*)(wp + (size_t)(256 * j + r) * q.Nsrc);
}
__device__ __forceinline__ void q8_item(const Q8Src& q, const Q8Src& qn, bool has_next, LAS unsigned char* lds, int tid, f32x4 (&v)[8][4]) {
    constexpr int LDT = 2064;
    const int s0 = 32 * q.item, cg = tid & 7, rl = tid >> 3, lane = tid & 63, wave = tid >> 6;
    f32x4 am = {0.f, 0.f, 0.f, 0.f};
#pragma unroll
    for (int j = 0; j < 8; ++j)
#pragma unroll
        for (int r = 0; r < 4; ++r)
#pragma unroll
            for (int c = 0; c < 4; ++c) am[c] = fmaxf(am[c], fabsf(v[j][r][c]));
#pragma unroll
    for (int c = 0; c < 4; ++c) { am[c] = fmaxf(am[c], __shfl_xor(am[c], 8)); am[c] = fmaxf(am[c], __shfl_xor(am[c], 16)); am[c] = fmaxf(am[c], __shfl_xor(am[c], 32)); }
    LAS float* red = (LAS float*)(lds + 32 * LDT);
    if (lane < 8) *(LAS f32x4*)(red + wave * 32 + 4 * cg) = am;
    __syncthreads();
    f32x4 cm = *(const LAS f32x4*)(red + 4 * cg);
#pragma unroll
    for (int w = 1; w < 8; ++w) { const f32x4 t = *(const LAS f32x4*)(red + w * 32 + 4 * cg); cm[0] = fmaxf(cm[0], t[0]); cm[1] = fmaxf(cm[1], t[1]); cm[2] = fmaxf(cm[2], t[2]); cm[3] = fmaxf(cm[3], t[3]); }
    f32x4 inv;
#pragma unroll
    for (int c = 0; c < 4; ++c) { cm[c] = fmaxf(cm[c], 1e-30f); inv[c] = 127.0f / cm[c]; }
#pragma unroll
    for (int j = 0; j < 8; ++j)
#pragma unroll
        for (int c = 0; c < 4; ++c) { unsigned d = 0;
#pragma unroll
            for (int r = 0; r < 4; ++r) d |= (unsigned)(__float2int_rn(v[j][r][c] * inv[c]) & 255) << (8 * r);
            *(LAS unsigned*)(lds + (4 * cg + c) * LDT + 4 * rl + 256 * j) = d; }
    if (has_next) q8_load(qn, tid, v);
    __syncthreads();
#pragma unroll
    for (int i = 0; i < 8; ++i) { const int pidx = tid + 512 * i, row = pidx >> 7, o = (pidx & 127) * 16; const int drow = q.map ? win_dst_row(s0 + row) : s0 + row;
        *(v4u*)(q.WT + (size_t)drow * 2048 + o) = *(const LAS v4u*)(lds + row * LDT + o); }
    if (tid < 8) {
#pragma unroll
        for (int c = 0; c < 4; ++c) { const int drow = q.map ? win_dst_row(s0 + 4 * cg + c) : s0 + 4 * cg + c; q.sw[drow] = cm[c] * (1.0f / 127.0f); } }
    __syncthreads();
}
template <bool BF> __device__ __forceinline__ void rms_rows(int lane, const void* X, const float* gain, bf16* O, signed char* O8, float* SX, int m0, int step, int M) {
    f32x4 g[8];
#pragma unroll
    for (int j = 0; j < 8; ++j) g[j] = *((const f32x4*)gain + lane + 64 * j);
    v2u rb[8]; f32x4 rf[8];
#define RR_LOAD(m) { _Pragma("unroll") for (int j = 0; j < 8; ++j) { if (BF) rb[j] = *((const v2u*)((const bf16*)X + (size_t)(m) * 2048) + lane + 64 * j); else rf[j] = *((const f32x4*)((const float*)X + (size_t)(m) * 2048) + lane + 64 * j); } }
    if (m0 < M) RR_LOAD(m0)
#pragma nounroll
    for (int m = m0; m < M; m += step) { f32x4 v[8]; float s = 0.f;
#pragma unroll
        for (int j = 0; j < 8; ++j) { if (BF) v[j] = (f32x4){bflo(rb[j].x), bfhi(rb[j].x), bflo(rb[j].y), bfhi(rb[j].y)}; else v[j] = rf[j]; s += (v[j].x * v[j].x + v[j].y * v[j].y) + (v[j].z * v[j].z + v[j].w * v[j].w); }
        if (m + step < M) RR_LOAD(m + step)
        const float rstd = 1.0f / sqrtf(wave_sum(s) * (1.f / 2048.f) + RMS_EPS); float am = 0.f;
        bf16* orow = O + (size_t)m * 2048; signed char* o8 = O8 + (size_t)m * 2048;
#pragma unroll
        for (int j = 0; j < 8; ++j) { v[j] = v[j] * rstd * g[j];
            v2u o; o.x = pk2(v[j].x, v[j].y); o.y = pk2(v[j].z, v[j].w);
            if (O) *((v2u*)orow + lane + 64 * j) = o;
            am = fmaxf(am, fmaxf(fmaxf(fabsf(v[j].x), fabsf(v[j].y)), fmaxf(fabsf(v[j].z), fabsf(v[j].w)))); }
#pragma unroll
        for (int o = 1; o < 64; o <<= 1) am = fmaxf(am, __shfl_xor(am, o));
        am = fmaxf(am, 1e-30f); const float sc = 127.0f / am;
#pragma unroll
        for (int j = 0; j < 8; ++j) { const int q0 = __float2int_rn(v[j].x * sc), q1 = __float2int_rn(v[j].y * sc), q2 = __float2int_rn(v[j].z * sc), q3 = __float2int_rn(v[j].w * sc);
            *((unsigned*)o8 + lane + 64 * j) = (unsigned)(q0 & 255) | ((unsigned)(q1 & 255) << 8) | ((unsigned)(q2 & 255) << 16) | ((unsigned)(q3 & 255) << 24); }
        if (lane == 0) SX[m] = am * (1.0f / 127.0f); }
#undef RR_LOAD
}
__device__ __forceinline__ void conv_plain(const float* src, bf16* dst, size_t n, size_t gtid, size_t gthreads) {
    for (size_t i = gtid * 8; i < n; i += gthreads * 8) { const f32x4 a = *(const f32x4*)(src + i), b = *(const f32x4*)(src + i + 4);
        v4u o; o.x = pk2(a.x, a.y); o.y = pk2(a.z, a.w); o.z = pk2(b.x, b.y); o.w = pk2(b.z, b.w); *(v4u*)(dst + i) = o; }
}
template <class A> __device__ __forceinline__ void p0_prologue(Frame& F, const A& args) {
    LAS float* scr = (LAS float*)(F.lds + RING_OFF + F.wave * 16384);
    const int gw = F.vcu * NWAVES + F.wave, NGW = F.G * NWAVES;
    constexpr int IT_WIN = 32 * (NWIN / 32), IT_UQ = 8 * 24, IT_UKV = 4 * 32, IT_W1 = 32 * 8, IT_W2 = 4 * 8, IT_BR = 8 * 64, IT_SQ = 32 * 64;
    constexpr int IT_LAYER = IT_UQ + IT_UKV + 2 * IT_W1 + 2 * IT_W2 + 4 * IT_BR + IT_SQ;
    auto tr_decode = [&](int it) -> TrSrc {
        const int l = it / IT_LAYER; int r = it % IT_LAYER; unsigned char* lw = F.ws + WS_W + (size_t)l * LW_BYTES;
        if (r < IT_UQ) return TrSrc{args.in[6] + (size_t)l * 512 * 768, 512, 768, (bf16*)(lw + LW_WUQ), 768, 0, 0, r}; r -= IT_UQ;
        if (r < IT_UKV) return TrSrc{args.in[7] + (size_t)l * 256 * 1024, 256, 1024, (bf16*)(lw + LW_WUKV), 1024, 2, 0, r}; r -= IT_UKV;
        if (r < IT_W1) return TrSrc{args.in[9] + (size_t)l * 2048 * 256, 2048, 256, (bf16*)(lw + LW_KCW1), 256, 0, 1, r}; r -= IT_W1;
        if (r < IT_W1) return TrSrc{args.in[12] + (size_t)l * 2048 * 256, 2048, 256, (bf16*)(lw + LW_VCW1), 256, 0, 1, r}; r -= IT_W1;
        if (r < IT_W2) return TrSrc{args.in[10] + (size_t)l * 256 * 64, 256, 64, (bf16*)(lw + LW_KCW2), 256, 3, 0, r}; r -= IT_W2;
        if (r < IT_W2) return TrSrc{args.in[13] + (size_t)l * 256 * 64, 256, 64, (bf16*)(lw + LW_VCW2), 256, 0, 0, r}; r -= IT_W2;
        if (r < 4 * IT_BR) { const int n = r / IT_BR; return TrSrc{args.in[14] + ((size_t)l * 4 + n) * 512 * 2048, 512, 2048, (bf16*)(lw + LW_WBR) + (size_t)n * 2048 * 512, 2048, 0, 0, r % IT_BR}; } r -= 4 * IT_BR;
        return TrSrc{args.in[15] + (size_t)l * 2048 * 2048, 2048, 2048, (bf16*)(lw + LW_WOUT), 2048, 0, 0, r}; };
    if (gw < NLAYER * IT_LAYER) { float tv[32]; TrSrc tc = tr_decode(gw); int sc = tr_load(tc, F.lane, tv);
#pragma nounroll
        for (int it = gw; it < NLAYER * IT_LAYER; it += NGW) { const bool has_next = it + NGW < NLAYER * IT_LAYER; const TrSrc tn = tr_decode(has_next ? it + NGW : it);
            float tc_v[32];
#pragma unroll
            for (int i = 0; i < 32; ++i) tc_v[i] = tv[i];
            const int sc_c = sc; if (has_next) sc = tr_load(tn, F.lane, tv);
            tr_finish(tc, sc_c, tc_v, scr, F.lane); tc = tn; } }
    const size_t gtid = (size_t)F.vcu * NTHR + F.tid, gthreads = (size_t)F.G * NTHR;
    for (int l = 0; l < NLAYER; ++l) { unsigned char* lw = F.ws + WS_W + (size_t)l * LW_BYTES;
        conv_plain(args.in[18] + (size_t)l * 131072, (bf16*)(lw + LW_SK1), 131072, gtid, gthreads);
        conv_plain(args.in[19] + (size_t)l * 131072, (bf16*)(lw + LW_SK2), 131072, gtid, gthreads);
    }
#define UV_SRC(r) (args.in[20 + (((r) >> 14) & 1)] + ((size_t)((r) >> 15) * 16384 + ((r) & 16383)) * 2048 + 32 * F.lane)
    { f32x4 v[8];
      if (gw < NLAYER * 2 * 16384) { const float* src = UV_SRC(gw);
#pragma unroll
          for (int j = 0; j < 8; ++j) v[j] = *((const f32x4*)src + j); }
#pragma nounroll
      for (int r = gw; r < NLAYER * 2 * 16384; r += NGW) { const int l = r >> 15, tb = (r >> 14) & 1, e = r & 16383; unsigned char* lw = F.ws + WS_W + (size_t)l * LW_BYTES;
        float am = 0.f; f32x4 c[8];
#pragma unroll
        for (int j = 0; j < 8; ++j) { c[j] = v[j]; am = fmaxf(am, fmaxf(fmaxf(fabsf(c[j].x), fabsf(c[j].y)), fmaxf(fabsf(c[j].z), fabsf(c[j].w)))); }
        if (r + NGW < NLAYER * 2 * 16384) { const float* src = UV_SRC(r + NGW);
#pragma unroll
            for (int j = 0; j < 8; ++j) v[j] = *((const f32x4*)src + j); }
#pragma unroll
        for (int o = 1; o < 64; o <<= 1) am = fmaxf(am, __shfl_xor(am, o));
        am = fmaxf(am, 1e-30f); const float sc = 7.0f / am;
        unsigned pk[7] = {0u, 0u, 0u, 0u, 0u, 0u, 0u};
#pragma unroll
        for (int i = 0; i < 32; ++i) { const float x = c[i >> 2][i & 3] * sc, ax = fabsf(x);
            int cd = ax < 2.0f ? __float2int_rn(ax * 8.0f) : ax < 4.0f ? 16 + __float2int_rn((ax - 2.0f) * 4.0f) : 24 + __float2int_rn((ax - 4.0f) * 2.0f); cd = cd > 31 ? 31 : cd;
            const unsigned code = (unsigned)cd | (x < 0.f ? 32u : 0u); const int bp = 6 * i, wd = bp >> 5, sh = bp & 31;
            pk[wd] |= code << sh; if (sh > 26) pk[wd + 1] |= code >> (32 - sh); }
        v2u* dst = (v2u*)(lw + (tb ? LW_V : LW_U) + ((size_t)(F.lane >> 3) * 16384 + e) * 192 + 24 * (F.lane & 7));     dst[0] = (v2u){pk[0], pk[1]}; dst[1] = (v2u){pk[2], pk[3]}; dst[2] = (v2u){pk[4], pk[5]};
        if (F.lane == 0) ((float*)(lw + (tb ? LW_SV : LW_SU)))[e] = am * (1.0f / 7.0f);
      } }
#undef UV_SRC
    for (size_t i = gtid; i < 2048 * 24; i += gthreads) { const int pos = (int)(i / 24), k = (int)(i % 24); const int half = k < 8 ? 8 : 16, idx = k < 8 ? k : k - 8;
        const float a = (-13.122363377404328f * (float)idx) / (float)half; const float inv = expf(a); const float ang = (float)pos * inv;
        const double x = (double)ang; const double nn = rint(x * 0.15915494309189535); const float rr = (float)(x - nn * 6.283185307179586);
        float* dst = (k < 8) ? (float*)(F.ws + WS_R16) + ((size_t)pos * 8 + idx) * 2 : (float*)(F.ws + WS_R32) + ((size_t)pos * 16 + idx) * 2;
        dst[0] = cosf(rr); dst[1] = sinf(rr); }
    for (size_t i = gtid; i < 4 * 8 * 512 / 2; i += gthreads) { const size_t s = i / (8 * 256), w = i % (8 * 256); const size_t o = (s * 1024 + 1016) * 256 + w;
        ((unsigned*)(F.ws + WS_ABK))[o] = 0u; ((unsigned*)(F.ws + WS_ABV))[o] = 0u; }
    for (size_t i = gtid; i < 2 * 8 * 128 * 64 / 2; i += gthreads) ((unsigned*)(F.ws + WS_KC))[i] = 0u;
    rms_rows<false>(F.lane, args.in[0], args.in[1], (bf16*)nullptr, (signed char*)(F.ws + WS_HN8), (float*)(F.ws + WS_SXH), gw, NGW, NTOK);
    for (int l = 0; l < NLAYER; ++l) { unsigned char* lw = F.ws + WS_W + (size_t)l * LW_BYTES;
        for (size_t i = gtid; i < (size_t)192 * 2048 / 4; i += gthreads) ((unsigned*)(lw + LW_WIN + (size_t)5184 * 2048))[i] = 0u;
        for (size_t i = gtid; i < 192; i += gthreads) ((float*)(lw + LW_SWIN))[5184 + i] = 0.f; }
}
template <class A> __device__ __forceinline__ Q8Src q8_decode(Frame& F, const A& args, int it) {
    constexpr int QI_WIN = NWIN_SRC / 32, QI_WQ = 64, QI_LAYER = QI_WIN + QI_WQ; const int l = it / QI_LAYER, r = it % QI_LAYER; unsigned char* lw = F.ws + WS_W + (size_t)l * LW_BYTES;
    if (r < QI_WIN) return Q8Src{args.in[2] + (size_t)l * 2048 * NWIN_SRC, NWIN_SRC, 1, r, (signed char*)(lw + LW_WIN), (float*)(lw + LW_SWIN)};
    return Q8Src{args.in[17] + (size_t)l * 2048 * 2048, 2048, 0, r - QI_WIN, (signed char*)(lw + LW_WQ), (float*)(lw + LW_SWQ)};
}
template <class A> __device__ __forceinline__ void p0_int8_weights(Frame& F, const A& args) {
    constexpr int QI_TOTAL = NLAYER * (NWIN_SRC / 32 + 64);
    f32x4 v[8][4]; int it = F.vcu; if (it >= QI_TOTAL) return;
    Q8Src q = q8_decode(F, args, it); q8_load(q, F.tid, v);
#pragma nounroll
    for (; it < QI_TOTAL; it += F.G) { const bool has_next = it + F.G < QI_TOTAL; const Q8Src qn = q8_decode(F, args, has_next ? it + F.G : it);
        q8_item(q, qn, has_next, F.lds + RING_OFF, F.tid, v); q = qn; }
}
__device__ __forceinline__ float logsigmoidf_(float x) { return fminf(x, 0.f) - __logf(1.0f + __expf(-fabsf(x))); }
template <class A> __device__ __forceinline__ void p2_fox(Frame& F, const A& args, int l) {
    const int gw = F.vcu * NWAVES + F.wave, NGW = F.G * NWAVES, lane = F.lane;
    const float* MISC = (const float*)(F.ws + WS_MISC); const bf16* ACT = (const bf16*)(F.ws + WS_ACT);
    if (gw >= NGW - 32) { const int bhw = gw - (NGW - 32); const int b = bhw >> 3, h = bhw & 7; const float bias = args.in[3][l * 8 + h]; float loc[32]; float run = 0.f;
#pragma unroll
        for (int i = 0; i < 32; ++i) { const int s = lane * 32 + i; run += logsigmoidf_(MISC[(size_t)(b * SEQ + s) * 64 + h] + bias); loc[i] = run; }
        float inc = run;
#pragma unroll
        for (int o = 1; o < 64; o <<= 1) { const float t = __shfl_up(inc, o); if (lane >= o) inc += t; }
        const float base = inc - run; float* Fo = (float*)(F.ws + WS_FCUM) + (size_t)bhw * SEQ + lane * 32;
#pragma unroll
        for (int i = 0; i < 32; ++i) Fo[i] = base + loc[i]; }
    for (int task = gw; task < 32 * 32; task += NGW) { const int bh = task >> 5, b = bh >> 3, h = bh & 7; const bf16* rowp = ACT + (size_t)(b * SEQ + (task & 31) * 64 + lane) * ACT_LD + h * 64; float qs = 0.f, ks = 0.f;
#pragma unroll
        for (int c = 0; c < 8; ++c) { const v4u qw = *(const v4u*)(rowp + C_FQ + c * 8), kw = *(const v4u*)(rowp + C_FK + c * 8);
            qs += bflo(qw.x) * bflo(qw.x) + bfhi(qw.x) * bfhi(qw.x) + bflo(qw.y) * bflo(qw.y) + bfhi(qw.y) * bfhi(qw.y) + bflo(qw.z) * bflo(qw.z) + bfhi(qw.z) * bfhi(qw.z) + bflo(qw.w) * bflo(qw.w) + bfhi(qw.w) * bfhi(qw.w);
            ks += bflo(kw.x) * bflo(kw.x) + bfhi(kw.x) * bfhi(kw.x) + bflo(kw.y) * bflo(kw.y) + bfhi(kw.y) * bfhi(kw.y) + bflo(kw.z) * bflo(kw.z) + bfhi(kw.z) * bfhi(kw.z) + bflo(kw.w) * bflo(kw.w) + bfhi(kw.w) * bfhi(kw.w); }
#pragma unroll
        for (int o = 1; o < 64; o <<= 1) { qs = fmaxf(qs, __shfl_xor(qs, o)); ks = fmaxf(ks, __shfl_xor(ks, o)); }
        if (lane == 0) { unsigned* nb = (unsigned*)(F.ctl + CW_FOXN) + l * 64 + bh * 2; atomicMax(nb, __float_as_uint(qs)); atomicMax(nb + 1, __float_as_uint(ks)); } }
}
template <class A> __device__ __forceinline__ void p2_q_rows(Frame& F, const A& args, int l, int tb) {
    const int lane = F.lane; const f32x4 g0 = *(const f32x4*)(args.in[4] + l * 512 + lane * 8), g1 = *(const f32x4*)(args.in[4] + l * 512 + lane * 8 + 4);
    v4u nx[8];
#define PQ_LOAD(r0) { _Pragma("unroll") for (int u = 0; u < 8; ++u) nx[u] = *(const v4u*)((const bf16*)(F.ws + WS_ACT) + (size_t)(tb + 32 * F.wave + (r0) + u) * ACT_LD + C_MCQ + lane * 8); }
    PQ_LOAD(0)
#pragma nounroll
    for (int r0 = 0; r0 < 32; r0 += 8) { v4u wq[8]; float s1[8];
#pragma unroll
        for (int u = 0; u < 8; ++u) wq[u] = nx[u];
#pragma unroll
        for (int u = 0; u < 8; ++u) { const v4u w = wq[u]; const float x[8] = {bflo(w.x), bfhi(w.x), bflo(w.y), bfhi(w.y), bflo(w.z), bfhi(w.z), bflo(w.w), bfhi(w.w)}; float s = 0.f;
#pragma unroll
            for (int i = 0; i < 8; ++i) s += x[i] * x[i];
            s1[u] = s; }
        if (r0 < 24) PQ_LOAD(r0 + 8)
#pragma unroll
        for (int o = 1; o < 64; o <<= 1) {
#pragma unroll
            for (int u = 0; u < 8; ++u) s1[u] += __shfl_xor(s1[u], o); }
#pragma unroll
        for (int u = 0; u < 8; ++u) { const int t = tb + 32 * F.wave + r0 + u; const float r1 = 1.0f / sqrtf(s1[u] * (1.f / 512.f) + RMS_EPS);
            const v4u w = wq[u]; const float x[8] = {bflo(w.x), bfhi(w.x), bflo(w.y), bfhi(w.y), bflo(w.z), bfhi(w.z), bflo(w.w), bfhi(w.w)};
            v4u o; o.x = pk2(x[0] * r1 * g0.x, x[1] * r1 * g0.y); o.y = pk2(x[2] * r1 * g0.z, x[3] * r1 * g0.w); o.z = pk2(x[4] * r1 * g1.x, x[5] * r1 * g1.y); o.w = pk2(x[6] * r1 * g1.z, x[7] * r1 * g1.w);
            *(v4u*)((bf16*)(F.ws + WS_CQN) + (size_t)t * 512 + lane * 8) = o; } }
#undef PQ_LOAD
}
template <class A> __device__ __forceinline__ void p2_kv_rows(Frame& F, const A& args, int l, int tb, int rope) {
    const int lane = F.lane; const f32x4 gk = *(const f32x4*)(args.in[5] + l * 256 + lane * 4); const int i16 = lane & 15, hq = lane >> 4;
    const float* MISC = (const float*)(F.ws + WS_MISC); const float* R32 = (const float*)(F.ws + WS_R32);
    v2u nx[8]; float nr[8][4];
#define PK_LOAD(r0) { _Pragma("unroll") for (int u = 0; u < 8; ++u) { const int t = tb + 32 * F.wave + (r0) + u; nx[u] = *(const v2u*)((const bf16*)(F.ws + WS_ACT) + (size_t)t * ACT_LD + C_MCKV + lane * 4); \
        if (rope) { const int pos = t & (SEQ - 1); nr[u][0] = MISC[(size_t)t * 64 + 8 + i16]; nr[u][1] = MISC[(size_t)t * 64 + 24 + i16]; nr[u][2] = R32[((size_t)pos * 16 + i16) * 2]; nr[u][3] = R32[((size_t)pos * 16 + i16) * 2 + 1]; } } }
    PK_LOAD(0)
#pragma nounroll
    for (int r0 = 0; r0 < 32; r0 += 8) { v2u wk[8]; float s2[8], rr[8][4];
#pragma unroll
        for (int u = 0; u < 8; ++u) { wk[u] = nx[u];
#pragma unroll
            for (int i = 0; i < 4; ++i) rr[u][i] = nr[u][i]; }
#pragma unroll
        for (int u = 0; u < 8; ++u) { const v2u w2 = wk[u]; const float y[4] = {bflo(w2.x), bfhi(w2.x), bflo(w2.y), bfhi(w2.y)}; s2[u] = (y[0] * y[0] + y[1] * y[1]) + (y[2] * y[2] + y[3] * y[3]); }
        if (r0 < 24) PK_LOAD(r0 + 8)
#pragma unroll
        for (int o = 1; o < 64; o <<= 1) {
#pragma unroll
            for (int u = 0; u < 8; ++u) s2[u] += __shfl_xor(s2[u], o); }
#pragma unroll
        for (int u = 0; u < 8; ++u) { const int t = tb + 32 * F.wave + r0 + u; const float r2 = 1.0f / sqrtf(s2[u] * (1.f / 256.f) + RMS_EPS);
            const v2u w2 = wk[u]; const float y[4] = {bflo(w2.x), bfhi(w2.x), bflo(w2.y), bfhi(w2.y)};
            v2u o2; o2.x = pk2(y[0] * r2 * gk.x, y[1] * r2 * gk.y); o2.y = pk2(y[2] * r2 * gk.z, y[3] * r2 * gk.w);
            *(v2u*)((bf16*)(F.ws + WS_CKVN) + (size_t)t * 256 + lane * 4) = o2;
            if (rope) {
                const float x1 = rr[u][0], x2 = rr[u][1], c = rr[u][2], sn = rr[u][3];
                const bf16 o1 = (bf16)f2bf(x1 * c - x2 * sn), ob = (bf16)f2bf(x1 * sn + x2 * c); bf16* KM = (bf16*)(F.ws + WS_KM);
#pragma unroll
                for (int hh = 0; hh < 2; ++hh) { bf16* kp = KM + (size_t)t * 768 + (2 * hq + hh) * 96 + 64; kp[i16] = o1; kp[16 + i16] = ob; } } } }
#undef PK_LOAD
}
template <class A> __device__ __forceinline__ void p2_cmp_rows(Frame& F, const A& args, int l, int which, int s, int pm) {
    const int lane = F.lane; const bf16* ACT = (const bf16*)(F.ws + WS_ACT); const float* pe0 = args.in[which ? 11 : 8] + (size_t)l * 2048;
    const int li = s * 8 + (lane >> 3), d = (lane & 7) * 8; const float* pe = pe0 + li * 64 + d; const f32x4 p0 = *(const f32x4*)pe, p1 = *(const f32x4*)(pe + 4);
    bf16* AB = (bf16*)(F.ws + (which ? WS_ABV : WS_ABK)) + (size_t)s * 1024 * 512;
    v4u nx[8];
#define PC_LOAD(r0) { _Pragma("unroll") for (int u = 0; u < 8; ++u) { int R = 256 * pm + 32 * F.wave + (r0) + u; R = R < 1016 ? R : 1015; const int g = R & 1, bc = R >> 1, b = bc / 127, c = bc - b * 127; \
            nx[u] = *(const v4u*)(ACT + (size_t)(b * SEQ + 16 * c + li) * ACT_LD + (which ? C_NVC : C_NKC) + g * 64 + d); } }
    PC_LOAD(0)
#pragma nounroll
    for (int r0 = 0; r0 < 32; r0 += 8) { v4u w[8];
#pragma unroll
        for (int u = 0; u < 8; ++u) w[u] = nx[u];
        if (r0 < 24) PC_LOAD(r0 + 8)
#pragma unroll
        for (int u = 0; u < 8; ++u) { const int R = 256 * pm + 32 * F.wave + r0 + u; if (R >= 1016) continue;
            v4u o; o.x = pk2(bflo(w[u].x) + p0.x, bfhi(w[u].x) + p0.y); o.y = pk2(bflo(w[u].y) + p0.z, bfhi(w[u].y) + p0.w); o.z = pk2(bflo(w[u].z) + p1.x, bfhi(w[u].z) + p1.y); o.w = pk2(bflo(w[u].w) + p1.z, bfhi(w[u].w) + p1.w);
            *(v4u*)(AB + (size_t)R * 512 + (li & 7) * 64 + d) = o; } }
}
constexpr int AT_K = 0, AT_V = 13312, AT_FK = 22016, AT_BUF = 22528  , AT_CK = 45056, AT_CV = 63488, AT_IMP = 80384, AT_SC = 114176, AT_SELM = 122624, AT_FLAG = 123392;
constexpr int VSTR = 136;
#define MFMA32(a, b, c) __builtin_amdgcn_mfma_f32_32x32x16_bf16((a), (b), (c), 0, 0, 0)
__device__ __forceinline__ unsigned cvtpk(float lo, float hi) { typedef __bf16 bf2 __attribute__((ext_vector_type(2))); f32x2 v = {lo, hi}; bf2 b = __builtin_convertvector(v, bf2); return __builtin_bit_cast(unsigned, b); }
__device__ __forceinline__ float ex2(float x) { return __builtin_amdgcn_exp2f(x); }

template <int NK> struct KRegs { v4u r[(NK * 2 * 64 + 511) / 512]; };
template <int NK> __device__ __forceinline__ void k_gload(KRegs<NK>& R, const bf16* Kg, int pitch, int tid) {
    constexpr int CH = NK * 2, N = CH * 64;
#pragma unroll
    for (int i = 0; i < (N + 511) / 512; ++i) { const int id = tid + i * 512; if (id < N) { const int row = id / CH, ch = id % CH; R.r[i] = *(const v4u*)(Kg + (size_t)row * pitch + ch * 8); } }
}
template <int NK, int KSTR> __device__ __forceinline__ void k_lwrite(const KRegs<NK>& R, LAS unsigned char* Kt, int tid) {
    constexpr int CH = NK * 2, N = CH * 64;
#pragma unroll
    for (int i = 0; i < (N + 511) / 512; ++i) { const int id = tid + i * 512; if (id < N) { const int row = id / CH, ch = id % CH; *(LAS v4u*)(Kt + row * KSTR + ch * 16) = R.r[i]; } }
}
__device__ __forceinline__ v4u v_gload(const bf16* VTg  , int tid) { return *(const v4u*)(VTg + (size_t)(tid >> 3) * VT_LD + (tid & 7) * 8); }
__device__ __forceinline__ void v_lwrite(v4u v, LAS unsigned char* Vt, int tid) { LAS unsigned char* p = Vt + (tid >> 3) * VSTR + (tid & 7) * 16; *(LAS v2u*)p = (v2u){v.x, v.y}; *(LAS v2u*)(p + 8) = (v2u){v.z, v.w}; }

template <int NK, int KSTR>
__device__ __forceinline__ void qk_tile(f32x16& s0, f32x16& s1, const LAS unsigned char* Kt, const bf16x8 (&qf)[NK], int r32, int hi) {
    f32x16 z = {}; s0 = z; s1 = z;
#pragma unroll
    for (int kk = 0; kk < NK; ++kk) {
        const bf16x8 a0 = *(const LAS bf16x8*)(Kt + r32 * KSTR + kk * 32 + hi * 16);
        const bf16x8 a1 = *(const LAS bf16x8*)(Kt + (r32 + 32) * KSTR + kk * 32 + hi * 16);
        s0 = MFMA32(a0, qf[kk], s0); s1 = MFMA32(a1, qf[kk], s1);
    }
}
template <int VS>
__device__ __forceinline__ void pv_tile(f32x16& o0, f32x16& o1, const LAS unsigned char* Vt, const f32x16& p0, const f32x16& p1, int r32, int hi, int koff) {
#pragma unroll
    for (int ks = 0; ks < 4; ++ks) {
        v4u pw;
        if (ks < 2) { const int b8 = 8 * (ks & 1); pw.x = cvtpk(p0[b8 + 0], p0[b8 + 1]); pw.y = cvtpk(p0[b8 + 2], p0[b8 + 3]); pw.z = cvtpk(p0[b8 + 4], p0[b8 + 5]); pw.w = cvtpk(p0[b8 + 6], p0[b8 + 7]); }
        else        { const int b8 = 8 * (ks & 1); pw.x = cvtpk(p1[b8 + 0], p1[b8 + 1]); pw.y = cvtpk(p1[b8 + 2], p1[b8 + 3]); pw.z = cvtpk(p1[b8 + 4], p1[b8 + 5]); pw.w = cvtpk(p1[b8 + 6], p1[b8 + 7]); }
        const bf16x8 pb = __builtin_bit_cast(bf16x8, pw);
        const LAS unsigned char* va = Vt + r32 * VS + koff + ks * 32 + hi * 8;
        const v2u x0 = *(const LAS v2u*)va, x1 = *(const LAS v2u*)(va + 16);
        const v2u y0 = *(const LAS v2u*)(va + 32 * VS), y1 = *(const LAS v2u*)(va + 32 * VS + 16);
        const bf16x8 a0 = __builtin_bit_cast(bf16x8, ((v4u){x0.x, x0.y, x1.x, x1.y}));
        const bf16x8 a1 = __builtin_bit_cast(bf16x8, ((v4u){y0.x, y0.y, y1.x, y1.y}));
        o0 = MFMA32(a0, pb, o0); o1 = MFMA32(a1, pb, o1);
    }
}
struct Sm { float m, l; f32x16 o0, o1; };
__device__ __forceinline__ void sm_init(Sm& s) { s.m = -INFINITY; s.l = 0.f; f32x16 z = {}; s.o0 = z; s.o1 = z; }
__device__ __forceinline__ void sm_update(Sm& st, f32x16& s0, f32x16& s1, float c1) {
    float mx = fmaxf(s0[0], s1[0]);
#pragma unroll
    for (int r = 1; r < 16; ++r) mx = fmaxf(mx, fmaxf(s0[r], s1[r]));
    mx = fmaxf(mx, __shfl_xor(mx, 32));
    float mn = fmaxf(st.m, mx);
    if (__any(st.m == -INFINITY ? mn != -INFINITY : (mn - st.m) * c1 > 8.0f)) { const float alpha = ex2(st.m == -INFINITY ? -INFINITY : (st.m - mn) * c1); st.l *= alpha; st.o0 *= alpha; st.o1 *= alpha; st.m = mn; }
    else mn = st.m;
    const float nmu = (mn == -INFINITY) ? 0.f : -mn * c1;
    float sum = 0.f;
#pragma unroll
    for (int r = 0; r < 16; ++r) { s0[r] = ex2(fmaf(s0[r], c1, nmu)); s1[r] = ex2(fmaf(s1[r], c1, nmu)); sum += s0[r] + s1[r]; }
    st.l += sum;
}
__device__ __forceinline__ float sm_inv_l(const Sm& st) { const float lt = st.l + __shfl_xor(st.l, 32); return lt > 0.f ? 1.0f / lt : 0.f; }
__device__ __forceinline__ void store_o(bf16* orow, const f32x16& o0, const f32x16& o1, int hi) {
#pragma unroll
    for (int a = 0; a < 2; ++a)
#pragma unroll
        for (int p2 = 0; p2 < 2; ++p2) { const f32x16& o = a ? o1 : o0; const int k = 2 * p2;
            unsigned ax = cvtpk(o[4 * k], o[4 * k + 1]), ay = cvtpk(o[4 * k + 2], o[4 * k + 3]), bx = cvtpk(o[4 * k + 4], o[4 * k + 5]), by = cvtpk(o[4 * k + 6], o[4 * k + 7]);
            { auto r = __builtin_amdgcn_permlane32_swap(ax, bx, false, false); ax = r[0]; bx = r[1]; }
            { auto r = __builtin_amdgcn_permlane32_swap(ay, by, false, false); ay = r[0]; by = r[1]; }
            *(v4u*)(orow + 32 * a + 16 * p2 + 8 * hi) = (v4u){ax, ay, bx, by}; }
}
struct MaskCausal { int qpos, qw0, hi; float c1;
    __device__ __forceinline__ bool active(int t) const { return 64 * t <= qw0 + 31; }
    __device__ __forceinline__ void apply(int t, f32x16& s0, f32x16& s1, const LAS unsigned char*) const {
        if (64 * t + 63 > qw0) {
#pragma unroll
            for (int r = 0; r < 16; ++r) { const int k0 = 64 * t + 8 * (r >> 2) + 4 * hi + (r & 3); if (k0 > qpos) s0[r] = -INFINITY; if (k0 + 32 > qpos) s1[r] = -INFINITY; } } }
};
struct MaskFox { int qpos, qw0, hi; float c1, fq;
    __device__ __forceinline__ bool active(int t) const { return 64 * t <= qw0 + 31; }
    __device__ __forceinline__ void apply(int t, f32x16& s0, f32x16& s1, const LAS unsigned char* lds) const {
        const bool nm = (64 * t + 63 > qw0); const LAS float* fk = (const LAS float*)(lds + AT_FK);
#pragma unroll
        for (int gq = 0; gq < 4; ++gq) { const f32x4 f0 = *(const LAS f32x4*)(fk + 8 * gq + 4 * hi), f1 = *(const LAS f32x4*)(fk + 32 + 8 * gq + 4 * hi);
#pragma unroll
            for (int i = 0; i < 4; ++i) { const int r = 4 * gq + i; s0[r] += fq - f0[i]; s1[r] += fq - f1[i]; } }
        if (nm) {
#pragma unroll
            for (int r = 0; r < 16; ++r) { const int k0 = 64 * t + 8 * (r >> 2) + 4 * hi + (r & 3); if (k0 > qpos) s0[r] = -INFINITY; if (k0 + 32 > qpos) s1[r] = -INFINITY; } } }
};
struct MaskNsa { int qpos, qw0, hi; float c1; unsigned sel; int qt, mode;
    __device__ __forceinline__ bool active(int t) const { return mode == 0 || (64 * t <= qw0 + 31 && 64 * t + 63 >= qw0 - 511); }
    __device__ __forceinline__ void apply(int t, f32x16& s0, f32x16& s1, const LAS unsigned char*) const {
        const bool off = (mode == 0) && !((sel >> t) & 1u); const int wlim = mode ? 512 : (1 << 30);
        const bool nm = (64 * t + 63 > qw0) || (mode && (64 * t < qw0 + 31 - 511));
        if (off) {
#pragma unroll
            for (int r = 0; r < 16; ++r) { s0[r] = -INFINITY; s1[r] = -INFINITY; } }
        if (nm) {
#pragma unroll
            for (int r = 0; r < 16; ++r) { const int k0 = 64 * t + 8 * (r >> 2) + 4 * hi + (r & 3);
                if (k0 > qpos || qpos - k0 >= wlim) s0[r] = -INFINITY; if (k0 + 32 > qpos || qpos - (k0 + 32) >= wlim) s1[r] = -INFINITY; } } }
};
template <int NK, int KSTR, bool FOX, class MaskF>
__device__ __forceinline__ void attn_loop(Frame& F, const bf16* Kg, int kpitch, const bf16* VTg, const float* Fg, unsigned tilemask, const bf16x8 (&qf)[NK], Sm& st, const MaskF& mf) {
    const int tid = F.tid, r32 = F.lane & 31, hi = F.lane >> 5; LAS unsigned char* lds = F.lds;
    unsigned rem = tilemask; if (!rem) return;
    int t = __ffs(rem) - 1; rem &= rem - 1;
    KRegs<NK> kr; v4u vr; float fr = 0.f;
    k_gload<NK>(kr, Kg + (size_t)(64 * t) * kpitch, kpitch, tid); vr = v_gload(VTg + 64 * t, tid); if (FOX && tid < 64) fr = 8.0f * Fg[64 * t + tid];
    __syncthreads();
    k_lwrite<NK, KSTR>(kr, lds + AT_K, tid); v_lwrite(vr, lds + AT_V, tid); if (FOX && tid < 64) ((LAS float*)(lds + AT_FK))[tid] = fr;
    int tc = t, cb = 0; bool more = rem != 0u;
    if (more) { t = __ffs(rem) - 1; rem &= rem - 1; k_gload<NK>(kr, Kg + (size_t)(64 * t) * kpitch, kpitch, tid); vr = v_gload(VTg + 64 * t, tid); if (FOX && tid < 64) fr = 8.0f * Fg[64 * t + tid]; }
    for (;;) {
        asm volatile("s_waitcnt lgkmcnt(0)" ::: "memory"); __builtin_amdgcn_s_barrier(); asm volatile("" ::: "memory");
        LAS unsigned char* cur = lds + cb * AT_BUF; LAS unsigned char* nxt = lds + (cb ^ 1) * AT_BUF;
        const int tn = t; const bool more2 = more;
        if (more) { k_lwrite<NK, KSTR>(kr, nxt + AT_K, tid); v_lwrite(vr, nxt + AT_V, tid); if (FOX && tid < 64) ((LAS float*)(nxt + AT_FK))[tid] = fr;
            more = rem != 0u;
            if (more) { t = __ffs(rem) - 1; rem &= rem - 1; k_gload<NK>(kr, Kg + (size_t)(64 * t) * kpitch, kpitch, tid); vr = v_gload(VTg + 64 * t, tid); if (FOX && tid < 64) fr = 8.0f * Fg[64 * t + tid]; } }
        if (mf.active(tc)) { f32x16 s0, s1; qk_tile<NK, KSTR>(s0, s1, cur + AT_K, qf, r32, hi);
#if XDUP == 1
            { f32x16 d0, d1; asm volatile("" : "+v"(s0), "+v"(s1)); qk_tile<NK, KSTR>(d0, d1, cur + AT_K, qf, r32, hi); asm volatile("" :: "v"(d0), "v"(d1)); }
#endif
            mf.apply(tc, s0, s1, cur);
#if XDUP == 2
            { f32x16 d0 = s0, d1 = s1; asm volatile("" : "+v"(d0), "+v"(d1)); float mx = fmaxf(d0[0], d1[0]);
              _Pragma("unroll") for (int r = 1; r < 16; ++r) mx = fmaxf(mx, fmaxf(d0[r], d1[r])); mx = fmaxf(mx, __shfl_xor(mx, 32)); const float nmu2 = (mx == -INFINITY) ? 0.f : -mx * mf.c1; float sm2 = 0.f;
              _Pragma("unroll") for (int r = 0; r < 16; ++r) { d0[r] = ex2(fmaf(d0[r], mf.c1, nmu2)); d1[r] = ex2(fmaf(d1[r], mf.c1, nmu2)); sm2 += d0[r] + d1[r]; } asm volatile("" :: "v"(sm2)); }
#endif
            sm_update(st, s0, s1, mf.c1);
#if XDUP == 3
            { f32x16 e0 = st.o0, e1 = st.o1; asm volatile("" : "+v"(e0), "+v"(e1)); pv_tile<VSTR>(e0, e1, cur + AT_V, s0, s1, r32, hi, 0); asm volatile("" :: "v"(e0), "v"(e1)); }
#endif
            pv_tile<VSTR>(st.o0, st.o1, cur + AT_V, s0, s1, r32, hi, 0); }
        if (!more2) break;
        tc = tn; cb ^= 1;
    }
}
__device__ __forceinline__ unsigned low_mask(int n) { return n >= 32 ? 0xffffffffu : ((1u << n) - 1u); }

__device__ __forceinline__ void fox_unit(Frame& F, int l, int b, int h, int qt) {
    const int r32 = F.lane & 31, hi = F.lane >> 5; const int qw0 = qt * 256 + 32 * F.wave, qpos = qw0 + r32; const size_t tq = (size_t)b * SEQ + qpos;
    const bf16* ACT = (const bf16*)(F.ws + WS_ACT); const float* Fg = (const float*)(F.ws + WS_FCUM) + (size_t)(b * 8 + h) * SEQ;
    bf16x8 qf[4];
#pragma unroll
    for (int kk = 0; kk < 4; ++kk) qf[kk] = *(const bf16x8*)(ACT + tq * ACT_LD + C_FQ + h * 64 + kk * 16 + hi * 8);
    Sm st; sm_init(st); MaskFox mf{qpos, qw0, hi, 0.125f * LOG2E, 8.0f * Fg[qpos]};
    int tlo = 4 * qt + 3; { const unsigned* nb = (const unsigned*)(F.ctl + CW_FOXN) + l * 64 + (b * 8 + h) * 2; const float B = 0.125f * 1.001f * sqrtf(__uint_as_float(nb[0])) * sqrtf(__uint_as_float(nb[1]));
      const float thr = -110.0f - 2.0f * B - Fg[qt * 256]; while (tlo > 0 && !(-Fg[64 * (tlo - 1) + 63] < thr)) --tlo; }
    attn_loop<4, 144, true>(F, ACT + (size_t)b * SEQ * ACT_LD + C_FK + h * 64, ACT_LD, (const bf16*)(F.ws + WS_VT) + (size_t)(R_FV + h * 64) * VT_LD + (size_t)b * SEQ, Fg, low_mask(4 * qt + 4) & ~low_mask(tlo), qf, st, mf);
    float il = sm_inv_l(st);
#if ABL == 1
    il = 0.f;
#endif
    st.o0 *= il; st.o1 *= il;
    store_o((bf16*)(F.ws + WS_BR) + tq * 512 + h * 64, st.o0, st.o1, hi);
}
__device__ __forceinline__ void mla_unit(Frame& F, int b, int h, int qt) {
    const int r32 = F.lane & 31, hi = F.lane >> 5; const int qw0 = qt * 256 + 32 * F.wave, qpos = qw0 + r32; const size_t tq = (size_t)b * SEQ + qpos;
    const bf16* QM = (const bf16*)(F.ws + WS_QM); const bf16* KM = (const bf16*)(F.ws + WS_KM);
    bf16x8 qf[6];
#pragma unroll
    for (int kk = 0; kk < 6; ++kk) qf[kk] = *(const bf16x8*)(QM + tq * 768 + h * 96 + kk * 16 + hi * 8);
    { const float* R32 = (const float*)(F.ws + WS_R32) + ((size_t)qpos * 16 + 8 * hi) * 2;
      v4u a = __builtin_bit_cast(v4u, qf[4]), bq = __builtin_bit_cast(v4u, qf[5]); unsigned ao[4], bo[4];
      const unsigned aw[4] = {a.x, a.y, a.z, a.w}, bw[4] = {bq.x, bq.y, bq.z, bq.w};
#pragma unroll
      for (int p = 0; p < 4; ++p) { const f32x4 cs = *(const f32x4*)(R32 + 4 * p);
          const float x1a = bflo(aw[p]), x1b = bfhi(aw[p]), x2a = bflo(bw[p]), x2b = bfhi(bw[p]);
          ao[p] = cvtpk(x1a * cs[0] - x2a * cs[1], x1b * cs[2] - x2b * cs[3]); bo[p] = cvtpk(x1a * cs[1] + x2a * cs[0], x1b * cs[3] + x2b * cs[2]); }
      qf[4] = __builtin_bit_cast(bf16x8, ((v4u){ao[0], ao[1], ao[2], ao[3]})); qf[5] = __builtin_bit_cast(bf16x8, ((v4u){bo[0], bo[1], bo[2], bo[3]})); }
    Sm st; sm_init(st); MaskCausal mf{qpos, qw0, hi, 0.10206207261596575f * LOG2E};
    attn_loop<6, 208, false>(F, KM + (size_t)b * SEQ * 768 + h * 96, 768, (const bf16*)(F.ws + WS_VT) + (size_t)(R_MV + h * 64) * VT_LD + (size_t)b * SEQ, nullptr, low_mask(4 * qt + 4), qf, st, mf);
    float il = sm_inv_l(st);
#if ABL == 2
    il = 0.f;
#endif
    st.o0 *= il; st.o1 *= il;
    store_o((bf16*)(F.ws + WS_BR) + ((size_t)NTOK + tq) * 512 + h * 64, st.o0, st.o1, hi);
}
__device__ __forceinline__ void sb_unit(Frame& F, int b, int h, int qt) {
    const int tid = F.tid, r32 = F.lane & 31, hi = F.lane >> 5; LAS unsigned char* lds = F.lds;
    const int qw0 = qt * 256 + 32 * F.wave, qpos = qw0 + r32; const size_t tq = (size_t)b * SEQ + qpos;
    const bf16* ACT = (const bf16*)(F.ws + WS_ACT);
    bf16x8 qf[4];
#pragma unroll
    for (int kk = 0; kk < 4; ++kk) qf[kk] = *(const bf16x8*)(ACT + tq * ACT_LD + C_SQ + h * 64 + kk * 16 + hi * 8);
    const bf16* Kg = ACT + (size_t)b * SEQ * ACT_LD + C_SK + h * 64; const bf16* VTg = (const bf16*)(F.ws + WS_VT) + (size_t)(R_SV + h * 64) * VT_LD + (size_t)b * SEQ;
    f32x16 o0 = {}, o1 = {}; float R = 0.f;
    int t = 4 * qt + 3; KRegs<4> kr; v4u vr;
    k_gload<4>(kr, Kg + (size_t)(64 * t) * ACT_LD, ACT_LD, tid); vr = v_gload(VTg + 64 * t, tid);
    volatile LAS unsigned* flag = (volatile LAS unsigned*)(lds + AT_FLAG);
    __syncthreads();
    k_lwrite<4, 144>(kr, lds + AT_K, tid); v_lwrite(vr, lds + AT_V, tid);
    int tc = t, cb = 0, it = 0; bool more = t > 0;
    if (more) { --t; k_gload<4>(kr, Kg + (size_t)(64 * t) * ACT_LD, ACT_LD, tid); vr = v_gload(VTg + 64 * t, tid); }
    for (;; ++it) {
        const bool wok = __all(R < -159.f); if (F.lane == 0) flag[(it & 1) * 8 + F.wave] = wok ? 1u : 0u;
        __syncthreads();
        unsigned allok = 1u;
#pragma unroll
        for (int w = 0; w < 8; ++w) allok &= flag[(it & 1) * 8 + w];
        if (allok) break;
        LAS unsigned char* cur = lds + cb * AT_BUF; LAS unsigned char* nxt = lds + (cb ^ 1) * AT_BUF;
        const int tn = t; const bool more2 = more;
        if (more) { k_lwrite<4, 144>(kr, nxt + AT_K, tid); v_lwrite(vr, nxt + AT_V, tid); more = t > 0;
            if (more) { --t; k_gload<4>(kr, Kg + (size_t)(64 * t) * ACT_LD, ACT_LD, tid); vr = v_gload(VTg + 64 * t, tid); } }
        if (64 * tc < qw0 + 31) {
            f32x16 s0, s1; qk_tile<4, 144>(s0, s1, cur + AT_K, qf, r32, hi);
            f32x16 lb0, lb1;
            const bool nm = (64 * tc + 63 >= qw0);
#pragma unroll
            for (int r = 0; r < 16; ++r) {
                const float z0 = s0[r] * (0.125f * LOG2E), z1 = s1[r] * (0.125f * LOG2E);
                const float l0 = fminf(z0, 0.f) - __builtin_amdgcn_logf(1.0f + ex2(-fabsf(z0))), l1 = fminf(z1, 0.f) - __builtin_amdgcn_logf(1.0f + ex2(-fabsf(z1)));
                lb0[r] = l0; lb1[r] = l1; s0[r] = l0 - z0; s1[r] = l1 - z1; }
            if (nm) {
#pragma unroll
                for (int r = 0; r < 16; ++r) { const int k0 = 64 * tc + 8 * (r >> 2) + 4 * hi + (r & 3); if (!(k0 < qpos)) s0[r] = 0.f; if (!(k0 + 32 < qpos)) s1[r] = 0.f; } }
            float mine[8], part[8];
#pragma unroll
            for (int gq = 0; gq < 4; ++gq) { mine[gq] = (s0[4 * gq] + s0[4 * gq + 1]) + (s0[4 * gq + 2] + s0[4 * gq + 3]); mine[4 + gq] = (s1[4 * gq] + s1[4 * gq + 1]) + (s1[4 * gq + 2] + s1[4 * gq + 3]); }
#pragma unroll
            for (int k = 0; k < 8; ++k) part[k] = __shfl_xor(mine[k], 32);
            float suf[17]; suf[16] = 0.f;
            float e[16];
#pragma unroll
            for (int k = 0; k < 8; ++k) { e[2 * k] = hi ? part[k] : mine[k]; e[2 * k + 1] = hi ? mine[k] : part[k]; }
            suf[15] = 0.f;
#pragma unroll
            for (int G = 14; G >= 0; --G) suf[G] = suf[G + 1] + e[G + 1];
            const float total = suf[0] + e[0];
#pragma unroll
            for (int k = 0; k < 8; ++k) { const float T = R + (hi ? suf[2 * k + 1] : suf[2 * k]);
                if (k < 4) { const int q4 = 4 * k; const float t3 = T, t2 = t3 + s0[q4 + 3], t1 = t2 + s0[q4 + 2], t0 = t1 + s0[q4 + 1];
                    s0[q4] = ex2(lb0[q4] + t0); s0[q4 + 1] = ex2(lb0[q4 + 1] + t1); s0[q4 + 2] = ex2(lb0[q4 + 2] + t2); s0[q4 + 3] = ex2(lb0[q4 + 3] + t3); }
                else { const int q4 = 4 * (k - 4); const float t3 = T, t2 = t3 + s1[q4 + 3], t1 = t2 + s1[q4 + 2], t0 = t1 + s1[q4 + 1];
                    s1[q4] = ex2(lb1[q4] + t0); s1[q4 + 1] = ex2(lb1[q4 + 1] + t1); s1[q4 + 2] = ex2(lb1[q4 + 2] + t2); s1[q4 + 3] = ex2(lb1[q4 + 3] + t3); } }
            if (nm) {
#pragma unroll
                for (int r = 0; r < 16; ++r) { const int k0 = 64 * tc + 8 * (r >> 2) + 4 * hi + (r & 3); if (!(k0 < qpos)) s0[r] = 0.f; if (!(k0 + 32 < qpos)) s1[r] = 0.f; } }
            R += total;
            pv_tile<VSTR>(o0, o1, cur + AT_V, s0, s1, r32, hi, 0);
        }
        if (!more2) break;
        tc = tn; cb ^= 1;
    }
    __syncthreads();
#if ABL == 6
    o0 *= 0.f; o1 *= 0.f;
#endif
    store_o((bf16*)(F.ws + WS_BR) + ((size_t)3 * NTOK + tq) * 512 + h * 64, o0, o1, hi);
}
__device__ __forceinline__ void nsa_unit(Frame& F, int b, int g, int qt) {
    const int tid = F.tid, lane = F.lane, r32 = lane & 31, hi = lane >> 5, wave = F.wave; LAS unsigned char* lds = F.lds;
    const int hh = g * 4 + (wave >> 1); const int q0 = 64 * qt, qw0 = q0 + 32 * (wave & 1), qpos = qw0 + r32; const size_t tq = (size_t)b * SEQ + qpos;
    const bf16* ACT = (const bf16*)(F.ws + WS_ACT); const float* MISC = (const float*)(F.ws + WS_MISC);
    const float c1 = 0.125f * LOG2E;
    bf16x8 qf[4];
#pragma unroll
    for (int kk = 0; kk < 4; ++kk) qf[kk] = *(const bf16x8*)(ACT + tq * ACT_LD + C_NQ + hh * 64 + kk * 16 + hi * 8);
    float g0 = sigmoidf_(MISC[tq * 64 + 40 + hh * 3]), g1 = sigmoidf_(MISC[tq * 64 + 40 + hh * 3 + 1]), g2 = sigmoidf_(MISC[tq * 64 + 40 + hh * 3 + 2]);
#if ABL == 3
    g0 = 0.f;
#elif ABL == 4
    g1 = 0.f;
#elif ABL == 5
    g2 = 0.f;
#endif
    __syncthreads();
    { const bf16* KC = (const bf16*)(F.ws + WS_KC) + (size_t)(b * 2 + g) * 128 * 64; const bf16* VC = (const bf16*)(F.ws + WS_VCT) + (size_t)(b * 2 + g) * 64 * 128;
#pragma unroll
      for (int i = 0; i < 2; ++i) { const int id = tid + i * 512; const v4u kv = *(const v4u*)(KC + (size_t)id * 8); *(LAS v4u*)(lds + AT_CK + (id >> 3) * 144 + (id & 7) * 16) = kv;
          const v4u vv = *(const v4u*)(VC + (size_t)id * 8); LAS unsigned char* p = lds + AT_CV + (id >> 4) * 264 + (id & 15) * 16; *(LAS v2u*)p = (v2u){vv.x, vv.y}; *(LAS v2u*)(p + 8) = (v2u){vv.z, vv.w}; } }
    __syncthreads();
    f32x16 acc0 = {}, acc1 = {};
    {
        f32x16 s[4];
        qk_tile<4, 144>(s[0], s[1], lds + AT_CK, qf, r32, hi); qk_tile<4, 144>(s[2], s[3], lds + AT_CK + 64 * 144, qf, r32, hi);
        const int ncv = qpos >= 31 ? ((qpos - 31) >> 4) + 1 : 0;
        float mx = -INFINITY;
#pragma unroll
        for (int a = 0; a < 4; ++a)
#pragma unroll
            for (int r = 0; r < 16; ++r) { const int c = 32 * a + 8 * (r >> 2) + 4 * hi + (r & 3); const float v = (c < ncv) ? s[a][r] * c1 : -INFINITY; s[a][r] = v; mx = fmaxf(mx, v); }
        mx = fmaxf(mx, __shfl_xor(mx, 32)); const float mu = (mx == -INFINITY) ? 0.f : mx; float sum = 0.f;
#pragma unroll
        for (int a = 0; a < 4; ++a)
#pragma unroll
            for (int r = 0; r < 16; ++r) { s[a][r] = ex2(s[a][r] - mu); sum += s[a][r]; }
        sum += __shfl_xor(sum, 32); const float inv = sum > 0.f ? 1.0f / sum : 0.f;
#pragma unroll
        for (int a = 0; a < 4; ++a) s[a] *= inv;
        f32x16 oc0 = {}, oc1 = {};
        pv_tile<264>(oc0, oc1, lds + AT_CV, s[0], s[1], r32, hi, 0); pv_tile<264>(oc0, oc1, lds + AT_CV, s[2], s[3], r32, hi, 128);
        acc0 = oc0 * g0; acc1 = oc1 * g0;
        LAS float* imp = (LAS float*)(lds + AT_IMP) + (wave * 32 + r32) * 33;
        float prevc = 0.f;
#pragma unroll
        for (int a = 0; a < 4; ++a)
#pragma unroll
            for (int gq = 0; gq < 4; ++gq) { const float inner = (s[a][4 * gq] + s[a][4 * gq + 1]) + (s[a][4 * gq + 2] + 0.5f * s[a][4 * gq + 3]); const float carry = 0.5f * s[a][4 * gq + 3];
                const float pc = __shfl_xor(carry, 32);
                imp[8 * a + 2 * gq + hi] = inner + (hi ? pc : prevc); prevc = pc; }
    }
    __syncthreads();
    {
        const int q = tid >> 3, j4 = (tid & 7) * 4; const int pos = q0 + q, cur = pos >> 6; const LAS float* impb = (const LAS float*)(lds + AT_IMP); LAS float* sc = (LAS float*)(lds + AT_SC);
#pragma unroll
        for (int jj = 0; jj < 4; ++jj) { const int j = j4 + jj; float v = 0.f;
#pragma unroll
            for (int hd = 0; hd < 4; ++hd) v += impb[((hd * 2 + (q >> 5)) * 32 + (q & 31)) * 33 + j];
            const bool valid = 64 * j <= pos; const bool forced = (j == 0) || (j == cur) || (j == cur - 1);
            sc[q * 33 + j] = valid ? v + (forced ? 1000.f : 0.f) : -1e30f; }
    }
    __syncthreads();
    {
        const LAS float* sc = (const LAS float*)(lds + AT_SC); LAS unsigned* selm = (LAS unsigned*)(lds + AT_SELM);
#pragma unroll
        for (int it = 0; it < 4; ++it) { const int q = 8 * wave + 2 * it + hi, j = r32; const float my = sc[q * 33 + j]; int rank = 0;
#pragma unroll
            for (int j2 = 0; j2 < 32; ++j2) { const float o = sc[q * 33 + j2]; rank += (o > my || (o == my && j2 < j)) ? 1 : 0; }
            const bool sel = rank < 16 && (64 * j <= q0 + q);
            const unsigned long long bal = __ballot(sel);
            if (lane == 0) selm[8 * wave + 2 * it] = (unsigned)bal; if (lane == 32) selm[8 * wave + 2 * it + 1] = (unsigned)(bal >> 32); }
    }
    __syncthreads();
    unsigned mysel, uni;
    { const LAS unsigned* selm = (const LAS unsigned*)(lds + AT_SELM); mysel = selm[32 * (wave & 1) + r32]; uni = selm[lane];
#pragma unroll
      for (int o = 1; o < 64; o <<= 1) uni |= __shfl_xor(uni, o); }
    const bf16* Kb = ACT + (size_t)b * SEQ * ACT_LD; const bf16* VTb = (const bf16*)(F.ws + WS_VT) + (size_t)b * SEQ;
    {
        const int tlo = (q0 - 511) > 0 ? (q0 - 511) >> 6 : 0;
#pragma nounroll
        for (int br = 0; br < 2; ++br) {
            Sm st; sm_init(st); MaskNsa mf{qpos, qw0, hi, c1, mysel, qt, br};
            const unsigned tiles = br ? (low_mask(qt + 1) & ~low_mask(tlo)) : (uni & low_mask(qt + 1));
            attn_loop<4, 144, false>(F, Kb + (br ? C_NKW : C_NKS) + g * 64, ACT_LD, VTb + (size_t)((br ? R_NVW : R_NVS) + g * 64) * VT_LD, nullptr, tiles, qf, st, mf);
            const float il = sm_inv_l(st) * (br ? g2 : g1); acc0 += st.o0 * il; acc1 += st.o1 * il;
        }
    }
    store_o((bf16*)(F.ws + WS_BR) + ((size_t)2 * NTOK + tq) * 512 + hh * 64, acc0, acc1, hi);
}
#define MFMA16(a, b, c) __builtin_amdgcn_mfma_f32_16x16x32_bf16((a), (b), (c), 0, 0, 0)
template <int CTRL> __device__ __forceinline__ float dppf(float v) { return __int_as_float(__builtin_amdgcn_update_dpp(0, __float_as_int(v), CTRL, 0xF, 0xF, true)); }
#define TK_CE(a, b) { const float t_ = fmaxf(a, b); b = fminf(a, b); a = t_; }
#define TK_SORT16(v, o) { TK_CE(v[(o) + 0], v[(o) + 1]) TK_CE(v[(o) + 2], v[(o) + 3]) TK_CE(v[(o) + 4], v[(o) + 5]) TK_CE(v[(o) + 6], v[(o) + 7]) TK_CE(v[(o) + 8], v[(o) + 9]) TK_CE(v[(o) + 10], v[(o) + 11]) TK_CE(v[(o) + 12], v[(o) + 13]) TK_CE(v[(o) + 14], v[(o) + 15]) TK_CE(v[(o) + 0], v[(o) + 2]) TK_CE(v[(o) + 1], v[(o) + 3]) TK_CE(v[(o) + 4], v[(o) + 6]) TK_CE(v[(o) + 5], v[(o) + 7]) TK_CE(v[(o) + 8], v[(o) + 10]) TK_CE(v[(o) + 9], v[(o) + 11]) TK_CE(v[(o) + 12], v[(o) + 14]) TK_CE(v[(o) + 13], v[(o) + 15]) TK_CE(v[(o) + 1], v[(o) + 2]) TK_CE(v[(o) + 5], v[(o) + 6]) TK_CE(v[(o) + 9], v[(o) + 10]) TK_CE(v[(o) + 13], v[(o) + 14]) TK_CE(v[(o) + 0], v[(o) + 4]) TK_CE(v[(o) + 1], v[(o) + 5]) TK_CE(v[(o) + 2], v[(o) + 6]) TK_CE(v[(o) + 3], v[(o) + 7]) TK_CE(v[(o) + 8], v[(o) + 12]) TK_CE(v[(o) + 9], v[(o) + 13]) TK_CE(v[(o) + 10], v[(o) + 14]) TK_CE(v[(o) + 11], v[(o) + 15]) TK_CE(v[(o) + 2], v[(o) + 4]) TK_CE(v[(o) + 3], v[(o) + 5]) TK_CE(v[(o) + 10], v[(o) + 12]) TK_CE(v[(o) + 11], v[(o) + 13]) TK_CE(v[(o) + 1], v[(o) + 2]) TK_CE(v[(o) + 3], v[(o) + 4]) TK_CE(v[(o) + 5], v[(o) + 6]) TK_CE(v[(o) + 9], v[(o) + 10]) TK_CE(v[(o) + 11], v[(o) + 12]) TK_CE(v[(o) + 13], v[(o) + 14]) TK_CE(v[(o) + 0], v[(o) + 8]) TK_CE(v[(o) + 1], v[(o) + 9]) TK_CE(v[(o) + 2], v[(o) + 10]) TK_CE(v[(o) + 3], v[(o) + 11]) TK_CE(v[(o) + 4], v[(o) + 12]) TK_CE(v[(o) + 5], v[(o) + 13]) TK_CE(v[(o) + 6], v[(o) + 14]) TK_CE(v[(o) + 7], v[(o) + 15]) TK_CE(v[(o) + 4], v[(o) + 8]) TK_CE(v[(o) + 5], v[(o) + 9]) TK_CE(v[(o) + 6], v[(o) + 10]) TK_CE(v[(o) + 7], v[(o) + 11]) TK_CE(v[(o) + 2], v[(o) + 4]) TK_CE(v[(o) + 3], v[(o) + 5]) TK_CE(v[(o) + 6], v[(o) + 8]) TK_CE(v[(o) + 7], v[(o) + 9]) TK_CE(v[(o) + 10], v[(o) + 12]) TK_CE(v[(o) + 11], v[(o) + 13]) TK_CE(v[(o) + 1], v[(o) + 2]) TK_CE(v[(o) + 3], v[(o) + 4]) TK_CE(v[(o) + 5], v[(o) + 6]) TK_CE(v[(o) + 7], v[(o) + 8]) TK_CE(v[(o) + 9], v[(o) + 10]) TK_CE(v[(o) + 11], v[(o) + 12]) TK_CE(v[(o) + 13], v[(o) + 14]) }
#define TK_BM4(v, o) { TK_CE(v[(o) + 0], v[(o) + 2]) TK_CE(v[(o) + 1], v[(o) + 3]) TK_CE(v[(o) + 0], v[(o) + 1]) TK_CE(v[(o) + 2], v[(o) + 3]) }
#define TK_BM8(v, o) { TK_CE(v[(o) + 0], v[(o) + 4]) TK_CE(v[(o) + 1], v[(o) + 5]) TK_CE(v[(o) + 2], v[(o) + 6]) TK_CE(v[(o) + 3], v[(o) + 7]) TK_CE(v[(o) + 0], v[(o) + 2]) TK_CE(v[(o) + 1], v[(o) + 3]) TK_CE(v[(o) + 4], v[(o) + 6]) TK_CE(v[(o) + 5], v[(o) + 7]) TK_CE(v[(o) + 0], v[(o) + 1]) TK_CE(v[(o) + 2], v[(o) + 3]) TK_CE(v[(o) + 4], v[(o) + 5]) TK_CE(v[(o) + 6], v[(o) + 7]) }
#define TK_BM16(v, o) { TK_CE(v[(o) + 0], v[(o) + 8]) TK_CE(v[(o) + 1], v[(o) + 9]) TK_CE(v[(o) + 2], v[(o) + 10]) TK_CE(v[(o) + 3], v[(o) + 11]) TK_CE(v[(o) + 4], v[(o) + 12]) TK_CE(v[(o) + 5], v[(o) + 13]) TK_CE(v[(o) + 6], v[(o) + 14]) TK_CE(v[(o) + 7], v[(o) + 15]) TK_CE(v[(o) + 0], v[(o) + 4]) TK_CE(v[(o) + 1], v[(o) + 5]) TK_CE(v[(o) + 2], v[(o) + 6]) TK_CE(v[(o) + 3], v[(o) + 7]) TK_CE(v[(o) + 8], v[(o) + 12]) TK_CE(v[(o) + 9], v[(o) + 13]) TK_CE(v[(o) + 10], v[(o) + 14]) TK_CE(v[(o) + 11], v[(o) + 15]) TK_CE(v[(o) + 0], v[(o) + 2]) TK_CE(v[(o) + 1], v[(o) + 3]) TK_CE(v[(o) + 4], v[(o) + 6]) TK_CE(v[(o) + 5], v[(o) + 7]) TK_CE(v[(o) + 8], v[(o) + 10]) TK_CE(v[(o) + 9], v[(o) + 11]) TK_CE(v[(o) + 12], v[(o) + 14]) TK_CE(v[(o) + 13], v[(o) + 15]) TK_CE(v[(o) + 0], v[(o) + 1]) TK_CE(v[(o) + 2], v[(o) + 3]) TK_CE(v[(o) + 4], v[(o) + 5]) TK_CE(v[(o) + 6], v[(o) + 7]) TK_CE(v[(o) + 8], v[(o) + 9]) TK_CE(v[(o) + 10], v[(o) + 11]) TK_CE(v[(o) + 12], v[(o) + 13]) TK_CE(v[(o) + 14], v[(o) + 15]) }
__device__ __forceinline__ void tk_side(const f32x16 (&acc)[4], unsigned hi4, float (&L)[16]) {
    float s[64];
#pragma unroll
    for (int kb = 0; kb < 4; ++kb)
#pragma unroll
        for (int r = 0; r < 16; ++r) s[16 * kb + r] = __uint_as_float(((__float_as_uint(acc[kb][r]) & ~127u) | hi4) | (unsigned)(32 * kb + (r & 3) + 8 * (r >> 2)));
    TK_SORT16(s, 0) TK_SORT16(s, 16) TK_SORT16(s, 32) TK_SORT16(s, 48)
#pragma unroll
    for (int i = 0; i < 16; ++i) { s[i] = fmaxf(s[i], s[31 - i]); s[32 + i] = fmaxf(s[32 + i], s[63 - i]); }
    TK_BM16(s, 0) TK_BM16(s, 32)
#pragma unroll
    for (int i = 0; i < 16; ++i) s[i] = fmaxf(s[i], s[47 - i]);
    TK_BM16(s, 0)
#pragma unroll
    for (int i = 0; i < 16; ++i) s[16 + i] = __shfl_xor(s[15 - i], 32);
#pragma unroll
    for (int i = 0; i < 16; ++i) s[i] = fmaxf(s[i], s[16 + i]);
    TK_BM16(s, 0)
#pragma unroll
    for (int i = 0; i < 16; ++i) L[i] = s[i];
}
constexpr int TK_SKLD = 272, TK_SKOFF = 20480, TK_SK2 = 128 * TK_SKLD;
__device__ __forceinline__ void peer_topk_stage(Frame& F, int l, int h) {
    unsigned char* lw = F.ws + WS_W + (size_t)l * LW_BYTES;
#pragma unroll
    for (int sd = 0; sd < 2; ++sd) { const bf16* SK = (const bf16*)(lw + (sd ? LW_SK2 : LW_SK1)) + (size_t)h * 128 * 128; v4u v[4];
#pragma unroll
        for (int i = 0; i < 4; ++i) v[i] = *(const v4u*)(SK + (size_t)(F.tid + 512 * i) * 8);
#pragma unroll
        for (int i = 0; i < 4; ++i) { const int id = F.tid + 512 * i; *(LAS v4u*)(F.lds + TK_SKOFF + sd * TK_SK2 + (id >> 4) * TK_SKLD + (id & 15) * 16) = v[i]; } }
}
__device__ __forceinline__ void peer_topk_task(Frame& F, int l, int tg, int h) {
    const int lane = F.lane, n = lane & 31, hi = lane >> 5; unsigned char* lw = F.ws + WS_W + (size_t)l * LW_BYTES;
    const bf16* QP = (const bf16*)(F.ws + WS_QP); int* EIDX = (int*)(F.ws + WS_EIDX); float* EGATE = (float*)(F.ws + WS_EGATE);
    float L1[16], L2[16];
#pragma unroll
    for (int sd = 0; sd < 2; ++sd) {
        bf16x8 af[8];
#pragma unroll
        for (int kk = 0; kk < 8; ++kk) af[kk] = *(const bf16x8*)(QP + (size_t)(32 * tg + n) * 2048 + h * 256 + sd * 128 + kk * 16 + hi * 8);
        const LAS unsigned char* SK = F.lds + TK_SKOFF + sd * TK_SK2;
        f32x16 acc[4];
#pragma unroll
        for (int kb = 0; kb < 4; ++kb) { f32x16 z = {}; acc[kb] = z;
#pragma unroll
            for (int kk = 0; kk < 8; ++kk) { const bf16x8 bfr = *(const LAS bf16x8*)(SK + (32 * kb + n) * TK_SKLD + kk * 32 + hi * 16); acc[kb] = MFMA32(bfr, af[kk], acc[kb]); } }
        if (sd == 0) tk_side(acc, (unsigned)hi << 2, L1); else tk_side(acc, (unsigned)hi << 2, L2);
    }
    LAS unsigned char* tb = F.lds + F.wave * 2560 + lane * 40;
#pragma unroll
    for (int q = 0; q < 4; ++q) {
        const unsigned w1 = (__float_as_uint(L1[15 - 4 * q]) & 127u) | ((__float_as_uint(L1[14 - 4 * q]) & 127u) << 8) | ((__float_as_uint(L1[13 - 4 * q]) & 127u) << 16) | ((__float_as_uint(L1[12 - 4 * q]) & 127u) << 24);
        const unsigned w2 = (__float_as_uint(L2[15 - 4 * q]) & 127u) | ((__float_as_uint(L2[14 - 4 * q]) & 127u) << 8) | ((__float_as_uint(L2[13 - 4 * q]) & 127u) << 16) | ((__float_as_uint(L2[12 - 4 * q]) & 127u) << 24);
        *(LAS unsigned*)(tb + 4 * q) = w1; *(LAS unsigned*)(tb + 16 + 4 * q) = w2; }
    float A[16], B[16];
#pragma unroll
    for (int i = 0; i < 16; ++i) { A[i] = __uint_as_float(__float_as_uint(L1[i]) & ~127u); B[i] = __uint_as_float(__float_as_uint(L2[i]) & ~127u); }
#define TK_C(i, j) __uint_as_float((__float_as_uint(A[i] + B[j]) & ~255u) | (unsigned)(((15 - (i)) << 4) | (15 - (j))))
    const float NI = -INFINITY;
    float t1[16], x1[16], x2[16], y[8], z[8];
#pragma unroll
    for (int j = 0; j < 16; ++j) t1[j] = TK_C(0, j);
#pragma unroll
    for (int j = 0; j < 8; ++j) { x1[j] = TK_C(1, j); x1[8 + j] = TK_C(15 - j, 0); }
    TK_BM16(x1, 0)
    y[0] = TK_C(3, 0); y[1] = TK_C(3, 1); y[2] = TK_C(3, 2); y[3] = TK_C(3, 3); y[4] = NI; y[5] = TK_C(4, 2); y[6] = TK_C(4, 1); y[7] = TK_C(4, 0);
    TK_BM8(y, 0)
    x2[0] = TK_C(2, 0); x2[1] = TK_C(2, 1); x2[2] = TK_C(2, 2); x2[3] = TK_C(2, 3); x2[4] = TK_C(2, 4); x2[5] = NI; x2[6] = NI; x2[7] = NI;
#pragma unroll
    for (int p = 0; p < 8; ++p) x2[8 + p] = y[7 - p];
    TK_BM16(x2, 0)
    z[0] = TK_C(5, 0); z[1] = TK_C(5, 1); z[2] = TK_C(6, 1); z[3] = TK_C(6, 0);
    TK_BM4(z, 0)
    z[4] = NI; z[5] = NI; z[6] = TK_C(7, 1); z[7] = TK_C(7, 0);
    TK_BM8(z, 0)
#pragma unroll
    for (int i = 0; i < 16; ++i) t1[i] = fmaxf(t1[i], x1[15 - i]);
    TK_BM16(t1, 0)
#pragma unroll
    for (int i = 8; i < 16; ++i) x2[i] = fmaxf(x2[i], z[15 - i]);
    TK_BM16(x2, 0)
#pragma unroll
    for (int i = 0; i < 16; ++i) t1[i] = fmaxf(t1[i], x2[15 - i]);
    TK_BM16(t1, 0)
#undef TK_C
    const float v0 = __uint_as_float(__float_as_uint(t1[0]) & ~255u);
    float ex[16]; float sum = 0.f;
#pragma unroll
    for (int k = 0; k < 16; ++k) { ex[k] = __expf(__uint_as_float(__float_as_uint(t1[k]) & ~255u) - v0); sum += ex[k]; }
    const float inv = 1.0f / sum;
    LDS_WAIT(); asm volatile("" ::: "memory");
    unsigned o[16];
#pragma unroll
    for (int k = 0; k < 16; ++k) { const unsigned id = __float_as_uint(t1[k]) & 255u;
        const unsigned i1 = *(LAS unsigned char*)(tb + (id >> 4)), i2 = *(LAS unsigned char*)(tb + 16 + (id & 15u));
        o[k] = hi ? __float_as_uint(ex[k] * inv) : (i1 * 128u + i2); }
    unsigned* dst = (hi ? (unsigned*)EGATE : (unsigned*)EIDX) + ((size_t)32 * tg + n) * 128 + h * 16;
#pragma unroll
    for (int q = 0; q < 4; ++q) *(v4u*)(dst + 4 * q) = (v4u){o[4 * q], o[4 * q + 1], o[4 * q + 2], o[4 * q + 3]};
}
typedef unsigned ps_v3u __attribute__((ext_vector_type(3))); typedef unsigned ps_v6u __attribute__((ext_vector_type(6))); typedef float ps_v32f __attribute__((ext_vector_type(32)));
__device__ __forceinline__ float dpp_add8(float v) {
    v += dppf<0xB1>(v); v += dppf<0x4E>(v); v += dppf<0x141>(v); return v;
}
constexpr int PS_LD = 132;
__device__ __forceinline__ void peer_u_slice(Frame& F, int l, int x, int ci) {
    const int lane = F.lane, tk = lane >> 3, cl = lane & 7; unsigned char* lw = F.ws + WS_W + (size_t)l * LW_BYTES;
    const unsigned char* U = lw + LW_U + (size_t)x * 16384 * 192; const signed char* HN8 = (const signed char*)(F.ws + WS_HN8); const int* EIDX = (const int*)(F.ws + WS_EIDX);
    float* AP = (float*)(F.ws + WS_ACT) + (size_t)x * NTOK * 128;
    LAS int* E = (LAS int*)(F.lds + RING_OFF + F.wave * 16384); LAS float* D = (LAS float*)(F.lds + RING_OFF + F.wave * 16384 + 8192);
#pragma nounroll
    for (int g = 0; g < 4; ++g) { const int tb = 256 * ci + 32 * F.wave + 8 * g, t = tb + tk;
        v4u xw[2]; { const v4u* xp = (const v4u*)(HN8 + (size_t)t * 2048 + 256 * x + 32 * cl); xw[0] = xp[0]; xw[1] = xp[1]; }
        int ei[16];
#pragma unroll
        for (int jj = 0; jj < 16; ++jj) ei[jj] = EIDX[(size_t)tb * 128 + jj * 64 + lane];
#pragma unroll
        for (int jj = 0; jj < 16; ++jj) { const int p = jj * 64 + lane; E[(p >> 7) * PS_LD + (p & 127)] = ei[jj]; }
        f32x2 xs[16];
#pragma unroll
        for (int q = 0; q < 2; ++q) { const unsigned w4[4] = {xw[q].x, xw[q].y, xw[q].z, xw[q].w};
#pragma unroll
            for (int d = 0; d < 4; ++d) { const int w = (int)w4[d]; xs[8 * q + 2 * d] = (f32x2){(float)((w << 24) >> 24), (float)((w << 16) >> 24)}; xs[8 * q + 2 * d + 1] = (f32x2){(float)((w << 8) >> 24), (float)(w >> 24)}; } }
        LDS_WAIT(); asm volatile("" ::: "memory");
        v4u ra[16]; v2u rb[16];
#define PA_REQ(k, e) { const unsigned o = (unsigned)E[tk * PS_LD + (e)] * 192u + 24u * (unsigned)cl; ra[k] = *(const v4u*)(U + (size_t)o); rb[k] = *(const v2u*)(U + (size_t)o + 16); }
#pragma unroll
        for (int k = 0; k < 16; ++k) PA_REQ(k, k)
        float dprev = 0.f;
#pragma nounroll
        for (int eb = 0; eb < 8; ++eb) { float sel0 = 0.f, sel1 = 0.f;
#pragma unroll
            for (int k = 0; k < 16; ++k) { float one = 1.0f; asm volatile("" : "+v"(one), "+v"(dprev));
                const ps_v32f f = __builtin_amdgcn_cvt_scalef32_pk32_f32_fp6((ps_v6u){ra[k].x, ra[k].y, ra[k].z, ra[k].w, rb[k].x, rb[k].y}, one);
                PA_REQ(k, (16 * eb + 16 + k) & 127)
                f32x2 s0 = {0.f, 0.f}, s1 = {0.f, 0.f}, s2 = {0.f, 0.f}, s3 = {0.f, 0.f};
#pragma unroll
                for (int q = 0; q < 16; q += 4) { s0 += (f32x2){f[2 * q], f[2 * q + 1]} * xs[q]; s1 += (f32x2){f[2 * q + 2], f[2 * q + 3]} * xs[q + 1]; s2 += (f32x2){f[2 * q + 4], f[2 * q + 5]} * xs[q + 2]; s3 += (f32x2){f[2 * q + 6], f[2 * q + 7]} * xs[q + 3]; }
                const f32x2 s = (s0 + s1) + (s2 + s3); dprev = dpp_add8(s.x + s.y);
                if (k < 8) sel0 = (cl == k) ? dprev : sel0; else sel1 = (cl == k - 8) ? dprev : sel1; }
            D[tk * 128 + 16 * eb + cl] = sel0; D[tk * 128 + 16 * eb + 8 + cl] = sel1; }
#undef PA_REQ
        LDS_WAIT(); asm volatile("" ::: "memory");
#pragma unroll
        for (int jj = 0; jj < 16; ++jj) AP[(size_t)tb * 128 + jj * 64 + lane] = D[jj * 64 + lane];
    }
}
__device__ __forceinline__ void peer_weights(Frame& F, int l, int tg) {
    unsigned char* lw = F.ws + WS_W + (size_t)l * LW_BYTES; const int* EIDX = (const int*)(F.ws + WS_EIDX); const float* EGATE = (const float*)(F.ws + WS_EGATE);
    const float* SU = (const float*)(lw + LW_SU); const float* SV = (const float*)(lw + LW_SV); const float* AP = (const float*)(F.ws + WS_ACT); v2u* EWG = (v2u*)(F.ws + WS_ACT + (size_t)8 * NTOK * 128 * 4); const float* SXH = (const float*)(F.ws + WS_SXH);
#pragma nounroll
    for (int k0 = 0; k0 < 8; k0 += 4) { float pa[4][8]; int er[4]; float eg[4], su[4], sv[4];
#pragma unroll
        for (int j = 0; j < 4; ++j) { const size_t p = (size_t)tg * 4096 + (k0 + j) * 512 + F.tid; er[j] = EIDX[p]; eg[j] = EGATE[p];
#pragma unroll
            for (int s = 0; s < 8; ++s) pa[j][s] = AP[(size_t)s * NTOK * 128 + p]; }
#pragma unroll
        for (int j = 0; j < 4; ++j) { su[j] = SU[er[j]]; sv[j] = SV[er[j]]; }
#pragma unroll
        for (int j = 0; j < 4; ++j) { const size_t p = (size_t)tg * 4096 + (k0 + j) * 512 + F.tid; const float a = (((pa[j][0] + pa[j][1]) + (pa[j][2] + pa[j][3])) + ((pa[j][4] + pa[j][5]) + (pa[j][6] + pa[j][7]))) * SXH[p >> 7];
            EWG[p] = (v2u){(unsigned)er[j], __float_as_uint(eg[j] * pg8::gelu1(a * su[j]) * sv[j])}; } }
}
__device__ __forceinline__ void peer_v_slice(Frame& F, int l, int x, int ci) {
    const int lane = F.lane, tk = lane >> 3, cl = lane & 7; unsigned char* lw = F.ws + WS_W + (size_t)l * LW_BYTES;
    const unsigned char* V = lw + LW_V + (size_t)x * 16384 * 192;
    const v2u* EWG = (const v2u*)(F.ws + WS_ACT + (size_t)8 * NTOK * 128 * 4);
    const bf16* XA = (const bf16*)(F.ws + WS_XA); bf16* XB = (bf16*)(F.ws + WS_XB);
    LAS v2u* EW = (LAS v2u*)(F.lds + RING_OFF + F.wave * 16384);
#pragma nounroll
    for (int g = 0; g < 4; ++g) { const int tb = 256 * ci + 32 * F.wave + 8 * g, t = tb + tk;
        { v2u ew[16];
#pragma unroll
          for (int jj = 0; jj < 16; ++jj) ew[jj] = EWG[(size_t)tb * 128 + jj * 64 + lane];
#pragma unroll
          for (int jj = 0; jj < 16; ++jj) { const int p = jj * 64 + lane; EW[(p >> 7) * PS_LD + (p & 127)] = ew[jj]; } }
        v4u xr[4]; { const v4u* xp = (const v4u*)(XA + (size_t)t * 2048 + 256 * x + 32 * cl); xr[0] = xp[0]; xr[1] = xp[1]; xr[2] = xp[2]; xr[3] = xp[3]; }
        LDS_WAIT(); asm volatile("" ::: "memory");
        v4u ra[16]; v2u rb[16];
#define PB_REQ(k, e) { const v2u ew = EW[tk * PS_LD + (e)]; const unsigned o = ew.x * 192u + 24u * (unsigned)cl; ra[k] = *(const v4u*)(V + (size_t)o); rb[k] = *(const v2u*)(V + (size_t)o + 16); }
#pragma unroll
        for (int k = 0; k < 16; ++k) PB_REQ(k, k)
        f32x2 acc[16];
#pragma unroll
        for (int q = 0; q < 16; ++q) acc[q] = (f32x2){0.f, 0.f};
#pragma nounroll
        for (int eb = 0; eb < 8; ++eb) {
#pragma unroll
            for (int k = 0; k < 16; ++k) { float one = 1.0f; const float w = __uint_as_float(EW[tk * PS_LD + 16 * eb + k].y);
                asm volatile("" : "+v"(one), "+v"(acc[0]), "+v"(acc[1]), "+v"(acc[2]), "+v"(acc[3]), "+v"(acc[4]), "+v"(acc[5]), "+v"(acc[6]), "+v"(acc[7]), "+v"(acc[8]), "+v"(acc[9]), "+v"(acc[10]), "+v"(acc[11]), "+v"(acc[12]), "+v"(acc[13]), "+v"(acc[14]), "+v"(acc[15]));
                const ps_v32f f = __builtin_amdgcn_cvt_scalef32_pk32_f32_fp6((ps_v6u){ra[k].x, ra[k].y, ra[k].z, ra[k].w, rb[k].x, rb[k].y}, one);
                PB_REQ(k, (16 * eb + 16 + k) & 127)
                const f32x2 w2 = {w, w};
#pragma unroll
                for (int q = 0; q < 16; ++q) acc[q] += w2 * (f32x2){f[2 * q], f[2 * q + 1]}; } }
#undef PB_REQ
        v4u po[4];
#pragma unroll
        for (int q = 0; q < 4; ++q) { const v4u w = xr[q];
            po[q] = (v4u){pk2(acc[4 * q].x + bflo(w.x), acc[4 * q].y + bfhi(w.x)), pk2(acc[4 * q + 1].x + bflo(w.y), acc[4 * q + 1].y + bfhi(w.y)), pk2(acc[4 * q + 2].x + bflo(w.z), acc[4 * q + 2].y + bfhi(w.z)), pk2(acc[4 * q + 3].x + bflo(w.w), acc[4 * q + 3].y + bfhi(w.w))}; }
        { v4u* op = (v4u*)(XB + (size_t)t * 2048 + 256 * x + 32 * cl); op[0] = po[0]; op[1] = po[1]; op[2] = po[2]; op[3] = po[3]; }
    }
}
__device__ __forceinline__ void rms_rows_out(int lane, const bf16* X, const float* gain, float* O, int m0, int step, int M) {
    f32x4 g[8];
#pragma unroll
    for (int j = 0; j < 8; ++j) g[j] = *((const f32x4*)gain + lane + 64 * j);
    v2u rb[8];
#define RO_LOAD(m) { _Pragma("unroll") for (int j = 0; j < 8; ++j) rb[j] = *((const v2u*)(X + (size_t)(m) * 2048) + lane + 64 * j); }
    if (m0 < M) RO_LOAD(m0)
#pragma nounroll
    for (int m = m0; m < M; m += step) { f32x4 v[8]; float s = 0.f;
#pragma unroll
        for (int j = 0; j < 8; ++j) { v[j] = (f32x4){bflo(rb[j].x), bfhi(rb[j].x), bflo(rb[j].y), bfhi(rb[j].y)}; s += (v[j].x * v[j].x + v[j].y * v[j].y) + (v[j].z * v[j].z + v[j].w * v[j].w); }
        if (m + step < M) RO_LOAD(m + step)
        const float rstd = 1.0f / sqrtf(wave_sum(s) * (1.f / 2048.f) + RMS_EPS);
#pragma unroll
        for (int j = 0; j < 8; ++j) *((f32x4*)(O + (size_t)m * 2048) + lane + 64 * j) = v[j] * rstd * g[j]; }
#undef RO_LOAD
}
#ifdef USE_PG8
#define GEMM_CALL(E, S) pg8::gemm_phase<E, S, true, true>
#else
#define GEMM_CALL(E, S) pg8::gemm_simple<E, S>
#endif
#ifndef DBLJ
#define DBLJ -1
#define DBLL 1
#endif
constexpr int PH_PER_LAYER = 12, NPH = 2 + NLAYER * PH_PER_LAYER;
struct Args { const float* in[23]; float* out; unsigned char* ws; int ph_lo, ph_hi; };
__global__ void __launch_bounds__(NWAVES * 64, 2) hybrid_fwd(Args args) {
    extern __shared__ __attribute__((aligned(16))) unsigned char lds[];
    Frame F;
    F.lds = (LAS unsigned char*)lds; F.MISCW = (volatile LAS unsigned*)(F.lds + MISC_OFF);
    F.tid = threadIdx.x; F.lane = F.tid & 63; F.wave = __builtin_amdgcn_readfirstlane(F.tid >> 6);
    F.G = gridDim.x; { const int bx = blockIdx.x; F.vcu = (F.G % 8 == 0) ? (bx % 8) * (F.G / 8) + bx / 8 : bx; }
    F.ws = args.ws; F.ctl = (gu32*)(args.ws + WS_CTL); F.out = args.out;
    for (int u = F.tid; u < (LDS_BYTES - LDSCTL_OFF) / 4; u += NWAVES * 64) ((LAS unsigned*)(F.lds + LDSCTL_OFF))[u] = 0u;
    __syncthreads();
    const int lo = args.ph_lo, hi = args.ph_hi; const bool multi = (hi - lo) > 1;
    XcdBarrier bar; bar.bar = (unsigned*)(F.ctl + CW_BAR); bar.x = 0; bar.st = nullptr;
    if (multi) bar = xcd_barrier_post((unsigned*)(F.ctl + CW_BAR), F.MISCW + 8);
#ifndef PHM
#define PHM 0xfff
#endif
#define IN(k) (lo <= (k) && (k) < hi)
#define ON(j) ((PHM >> (j)) & 1)
#define SEAM(k) do { if (IN(k) && IN((k) + 1)) xcd_barrier(bar); } while (0)
    int bx = (int)blockIdx.x;
#define PH_BEGIN() do { asm volatile("" : "+v"(F.tid), "+v"(F.lane)); asm volatile("" : "+s"(F.wave), "+s"(bx), "+s"(F.ws)); } while (0)
    if (ON(0) && IN(0)) for (int rep_ = 0; rep_ < ((DBLJ == 11) ? 2 : 1); ++rep_) { if (rep_) xcd_barrier(bar); PH_BEGIN(); p0_int8_weights(F, args); PH_BEGIN(); p0_prologue(F, args); } SEAM(0);
    for (int l = 0; l < NLAYER; ++l) {
        const int pb = 2 + l * PH_PER_LAYER;
        if (ON(1) && IN(pb + 0)) for (int rep_ = 0; rep_ < ((DBLJ == 0 && l == DBLL) ? 2 : 1); ++rep_) { if (rep_) xcd_barrier(bar); PH_BEGIN(); unsigned char* lw = F.ws + WS_W + (size_t)l * LW_BYTES; (void)lw;
            { pg8::Gemm g{(const bf16*)(F.ws + WS_HN8), (const bf16*)(lw + LW_WIN), NTOK, NWIN, 1024}; pg8::StaticOrder S; S.init(NTOK, NWIN, F.G, bx);
              pg8::EpiWin E{(bf16*)(F.ws + WS_ACT), (bf16*)(F.ws + WS_GATE), (float*)(F.ws + WS_MISC), (bf16*)(F.ws + WS_VT), (const float*)(F.ws + WS_R16), (const float*)(F.ws + WS_SXH), (const float*)(lw + LW_SWIN)};
              pg8::gemm_phase<pg8::EpiWin, pg8::StaticOrder, true, true, true>(F.lds + RING_OFF, g, S, E); }
        } SEAM(pb + 0);
        if (ON(3) && IN(pb + 1)) for (int rep_ = 0; rep_ < ((DBLJ == 2 && l == DBLL) ? 2 : 1); ++rep_) { if (rep_) xcd_barrier(bar); PH_BEGIN(); unsigned char* lw = F.ws + WS_W + (size_t)l * LW_BYTES; (void)lw;
            if (bx < 224) {
                { const int N0 = bx < 96 ? 768 : 1024, G0 = bx < 96 ? 96 : 128, c0 = bx < 96 ? bx : bx - 96; pg8::StaticOrder S0; S0.init(NTOK, N0, G0, c0); pg8::Unit u0; (void)S0.next(0, u0);
                  if (bx < 96) p2_q_rows(F, args, l, 256 * u0.pm); else p2_kv_rows(F, args, l, 256 * u0.pm, u0.pn == 0 ? 1 : 0);
                  asm volatile("s_waitcnt vmcnt(0)" ::: "memory"); __syncthreads(); }
                asm volatile("" : "+v"(F.tid), "+v"(F.lane)); asm volatile("" : "+s"(F.wave), "+s"(bx), "+s"(F.ws));
                unsigned char* lw2 = F.ws + WS_W + (size_t)l * LW_BYTES;
                pg8::Gemm g{nullptr, nullptr, 0, 0, 0}; pg8::EpiGen E{nullptr, 0, 64, 0, 1 << 30, 0, 1 << 30, 1 << 30, (bf16*)(F.ws + WS_VT)}; int Gs = 0, cs = -1, M = 0, N = 0;
                if (bx < 96) { g = pg8::Gemm{(const bf16*)(F.ws + WS_CQN), (const bf16*)(lw2 + LW_WUQ), NTOK, 768, 512}; E.O = (bf16*)(F.ws + WS_QM); E.ld = 768; Gs = 96; cs = bx; M = NTOK; N = 768; }
                else { g = pg8::Gemm{(const bf16*)(F.ws + WS_CKVN), (const bf16*)(lw2 + LW_WUKV), NTOK, 1024, 256}; E.O = (bf16*)(F.ws + WS_KM); E.ld = 768; E.hs = 96; E.vt_split = 512; E.vt_row0 = R_MV; Gs = 128; cs = bx - 96; M = NTOK; N = 1024; }
                pg8::StaticOrder S; S.init(M, N, Gs, cs); GEMM_CALL(pg8::EpiGen, pg8::StaticOrder)(F.lds + RING_OFF, g, S, E); }
            else if (bx >= 224) { const int isv = (bx - 224) >> 4, c = (bx - 224) & 15;
                p2_cmp_rows(F, args, l, isv, c >> 2, c & 3); asm volatile("s_waitcnt vmcnt(0)" ::: "memory"); __syncthreads();
                pg8::Gemm g2{(const bf16*)(F.ws + (isv ? WS_ABV : WS_ABK)), (const bf16*)(lw + (isv ? LW_VCW1 : LW_KCW1)), 4096, 1024, 512}; pg8::SliceOrder S2{c};
                pg8::EpiPart E2{(float*)(F.ws + WS_Z) + (size_t)isv * 4 * 1024 * 256};
                GEMM_CALL(pg8::EpiPart, pg8::SliceOrder)(F.lds + RING_OFF, g2, S2, E2); }
            asm volatile("" : "+v"(F.tid), "+v"(F.lane)); asm volatile("" : "+s"(F.wave), "+s"(bx), "+s"(F.ws));
            p2_fox(F, args, l);
        } SEAM(pb + 1);
        if (ON(4) && IN(pb + 2)) for (int rep_ = 0; rep_ < ((DBLJ == 3 && l == DBLL) ? 2 : 1); ++rep_) { if (rep_) xcd_barrier(bar); PH_BEGIN(); unsigned char* lw = F.ws + WS_W + (size_t)l * LW_BYTES; (void)lw;
            const int bh = (bx & 7) * 4 + (bx >> 6), j = (bx >> 3) & 7, b = bh >> 3, h = bh & 7;     gu32* nsaflag = F.ctl + CW_NSAF + 64 * (2 * l + rep_);
            if (j == 6 && bh < 8) { const int isv = bh >> 2;
                {
                    const float* PT = (const float*)(F.ws + WS_Z) + (size_t)isv * 4 * 1024 * 256 + (size_t)(bh & 3) * 256 * 256; bf16* HO = (bf16*)(F.ws + (isv ? WS_HV : WS_HK)) + (size_t)(bh & 3) * 256 * 256;
                    f32x4 pt[4][4];
#define CP_LOAD(it) { _Pragma("unroll") for (int q = 0; q < 4; ++q) { const size_t idx = (size_t)F.tid + (size_t)NTHR * (4 * (it) + q); _Pragma("unroll") for (int sl = 0; sl < 4; ++sl) pt[q][sl] = *(const f32x4*)(PT + (size_t)sl * 1024 * 256 + idx * 4); } }
                    CP_LOAD(0)
#pragma nounroll
                    for (int it = 0; it < 8; ++it) { f32x4 sacc[4];
#pragma unroll
                        for (int q = 0; q < 4; ++q) sacc[q] = (pt[q][0] + pt[q][1]) + (pt[q][2] + pt[q][3]);
                        if (it < 7) CP_LOAD(it + 1)
#pragma unroll
                        for (int q = 0; q < 4; ++q) { const size_t idx = (size_t)F.tid + (size_t)NTHR * (4 * it + q);
                            const f32x2 g0 = pg8::gelu_pk((f32x2){sacc[q][0], sacc[q][1]}), g1 = pg8::gelu_pk((f32x2){sacc[q][2], sacc[q][3]});
                            *(v2u*)(HO + idx * 4) = (v2u){pk2(g0.x, g0.y), pk2(g1.x, g1.y)}; } }
#undef CP_LOAD
                    asm volatile("s_waitcnt vmcnt(0)" ::: "memory"); __syncthreads(); }
                pg8::Gemm g{(const bf16*)(F.ws + (isv ? WS_HV : WS_HK)), (const bf16*)(lw + (isv ? LW_VCW2 : LW_KCW2)), 1024, 256, 256}; pg8::StaticOrder S; S.init(1024, 256, 4, bh & 3);
                pg8::EpiCmp2 E{(bf16*)(F.ws + (isv ? WS_VCT : WS_KC)), isv ? 0 : 1, (const float*)(F.ws + WS_R16)};
                GEMM_CALL(pg8::EpiCmp2, pg8::StaticOrder)(F.lds + RING_OFF, g, S, E);
                asm volatile("s_waitcnt vmcnt(0)" ::: "memory"); __syncthreads();
                if (F.tid == 0) { __builtin_amdgcn_fence(__ATOMIC_RELEASE, "agent"); asm volatile("s_waitcnt vmcnt(0)" ::: "memory"); (void)__hip_atomic_fetch_add(nsaflag, 1u, RLX_AGENT); }
                __syncthreads(); }
            mla_unit(F, b, h, j);
#if UDBL == 1
            mla_unit(F, b, h, j);
#endif
            const unsigned foxm = j == 0 ? 0x0Eu : j == 1 ? 0x21u : j == 2 ? 0x80u : j == 4 ? 0x10u : j == 5 ? 0x40u : 0u;
            const unsigned sbm = j == 0 ? 0x03u : j == 1 ? 0x0Cu : j == 2 ? 0x30u : j == 3 ? 0xC0u : 0u;
#pragma nounroll
            for (int q = 0; q < 8; ++q) if ((foxm >> q) & 1u) fox_unit(F, l, b, h, q);
#pragma nounroll
            for (int q = 0; q < 8; ++q) if ((sbm >> q) & 1u) sb_unit(F, b, h, q);
#if UDBL == 3
#pragma nounroll
            for (int q = 0; q < 8; ++q) if ((sbm >> q) & 1u) sb_unit(F, b, h, q);
#endif
#if UDBL == 4
#pragma nounroll
            for (int q = 0; q < 8; ++q) if ((foxm >> q) & 1u) fox_unit(F, l, b, h, q);
#endif
            {
                if (F.tid == 0) { unsigned sp = 0; while (__hip_atomic_load(nsaflag, RLX_AGENT) < 8u) { __builtin_amdgcn_s_sleep(4); if (++sp > (1u << 22)) break; }
                    __builtin_amdgcn_fence(__ATOMIC_ACQUIRE, "agent"); asm volatile("s_waitcnt vmcnt(0)" ::: "memory"); }
                __syncthreads();
                const int ii = j < 4 ? j : 11 - j; nsa_unit(F, b, h >> 2, (h & 3) + 4 * ii);
#if UDBL == 2
                nsa_unit(F, b, h >> 2, (h & 3) + 4 * ii);
#endif
            }
        } SEAM(pb + 2);
        if (ON(6) && IN(pb + 3)) for (int rep_ = 0; rep_ < ((DBLJ == 5 && l == DBLL) ? 2 : 1); ++rep_) { if (rep_) xcd_barrier(bar); PH_BEGIN(); unsigned char* lw = F.ws + WS_W + (size_t)l * LW_BYTES; (void)lw;
            pg8::Gemm g{(const bf16*)(F.ws + WS_BR), (const bf16*)(lw + LW_WBR), 4 * NTOK, 4 * 2048, 512}; pg8::BranchOrder S{F.G, (bx & 7) * 32 + (bx >> 3)};
            pg8::EpiBranch E{(const bf16*)(F.ws + WS_GATE), (bf16*)(F.ws + WS_ZF), (bf16*)(F.ws + WS_Z)};
            GEMM_CALL(pg8::EpiBranch, pg8::BranchOrder)(F.lds + RING_OFF, g, S, E);
        } SEAM(pb + 3);
        if (ON(7) && IN(pb + 4)) for (int rep_ = 0; rep_ < ((DBLJ == 6 && l == DBLL) ? 2 : 1); ++rep_) { if (rep_) xcd_barrier(bar); PH_BEGIN(); unsigned char* lw = F.ws + WS_W + (size_t)l * LW_BYTES; (void)lw;
            pg8::Gemm g{(const bf16*)(F.ws + WS_Z), (const bf16*)(lw + LW_WOUT), NTOK, 2048, 2048}; pg8::StaticOrder S; S.init(NTOK, 2048, F.G, bx);
            pg8::EpiResid E{l == 0 ? args.in[0] : nullptr, l == 0 ? nullptr : (const bf16*)(F.ws + WS_XB), (bf16*)(F.ws + WS_XA)};
            GEMM_CALL(pg8::EpiResid, pg8::StaticOrder)(F.lds + RING_OFF, g, S, E);
        } SEAM(pb + 4);
        if (ON(8) && IN(pb + 5)) for (int rep_ = 0; rep_ < ((DBLJ == 7 && l == DBLL) ? 2 : 1); ++rep_) { if (rep_) xcd_barrier(bar); PH_BEGIN(); unsigned char* lw = F.ws + WS_W + (size_t)l * LW_BYTES; (void)lw; const int gw = F.vcu * NWAVES + F.wave, NGW = F.G * NWAVES;
            rms_rows<true>(F.lane, F.ws + WS_XA, args.in[16] + (size_t)l * 2048, (bf16*)nullptr, (signed char*)(F.ws + WS_HN8), (float*)(F.ws + WS_SXH), gw, NGW, NTOK);
        } SEAM(pb + 5);
        if (ON(9) && IN(pb + 6)) for (int rep_ = 0; rep_ < ((DBLJ == 8 && l == DBLL) ? 2 : 1); ++rep_) { if (rep_) xcd_barrier(bar); PH_BEGIN(); unsigned char* lw = F.ws + WS_W + (size_t)l * LW_BYTES; (void)lw;
#ifdef P9_BF16
            pg8::Gemm g{(const bf16*)(F.ws + WS_HN), (const bf16*)(lw + LW_WQB), NTOK, 2048, 2048}; pg8::StaticOrder S; S.init(NTOK, 2048, F.G, bx);
            pg8::EpiGen E{(bf16*)(F.ws + WS_QP), 2048, 64, 0, 1 << 30, 0, 1 << 30, 1 << 30, (bf16*)(F.ws + WS_VT)};
            GEMM_CALL(pg8::EpiGen, pg8::StaticOrder)(F.lds + RING_OFF, g, S, E);
#else
            pg8::Gemm g{(const bf16*)(F.ws + WS_HN8), (const bf16*)(lw + LW_WQ), NTOK, 2048, 1024}; pg8::StaticOrder S; S.init(NTOK, 2048, F.G, bx);
            pg8::EpiQ8 E{(bf16*)(F.ws + WS_QP), 2048, (const float*)(F.ws + WS_SXH), (const float*)(lw + LW_SWQ)};
            pg8::gemm_phase<pg8::EpiQ8, pg8::StaticOrder, true, true, true>(F.lds + RING_OFF, g, S, E);
#endif
        } SEAM(pb + 6);
        if (ON(10) && IN(pb + 7)) for (int rep_ = 0; rep_ < ((DBLJ == 9 && l == DBLL) ? 2 : 1); ++rep_) { if (rep_) xcd_barrier(bar); PH_BEGIN();
            for (int un = bx; un < 256; un += F.G) { const int pm = un >> 3, hd = un & 7;
                __syncthreads(); peer_topk_stage(F, l, hd); __syncthreads();
                peer_topk_task(F, l, 8 * pm + F.wave, hd); }
        } SEAM(pb + 7);
        if (ON(10) && IN(pb + 8)) for (int rep_ = 0; rep_ < ((DBLJ == 12 && l == DBLL) ? 2 : 1); ++rep_) { if (rep_) xcd_barrier(bar); PH_BEGIN(); peer_u_slice(F, l, bx & 7, bx >> 3); } SEAM(pb + 8);
        if (ON(10) && IN(pb + 9)) { PH_BEGIN(); for (int tg = bx; tg < 256; tg += F.G) peer_weights(F, l, tg); } SEAM(pb + 9);
        if (ON(10) && IN(pb + 10)) for (int rep_ = 0; rep_ < ((DBLJ == 13 && l == DBLL) ? 2 : 1); ++rep_) { if (rep_) xcd_barrier(bar); PH_BEGIN(); peer_v_slice(F, l, bx & 7, bx >> 3); } SEAM(pb + 10);
        if (ON(10) && IN(pb + 11)) { PH_BEGIN(); const int gw = F.vcu * NWAVES + F.wave, NGW = F.G * NWAVES;
            if (l + 1 < NLAYER) rms_rows<true>(F.lane, F.ws + WS_XB, args.in[1] + (size_t)(l + 1) * 2048, (bf16*)nullptr, (signed char*)(F.ws + WS_HN8), (float*)(F.ws + WS_SXH), gw, NGW, NTOK);
            else rms_rows_out(F.lane, (const bf16*)(F.ws + WS_XB), args.in[22], F.out, gw, NGW, NTOK);
        } SEAM(pb + 11);
    }
#undef IN
#undef SEAM
}

extern "C" void kernel_launch(void* const* d_in, const int* in_sizes, int n_in, void* d_out, int out_size, void* d_ws, size_t ws_size, hipStream_t stream) {
    static int grid = 0;
    if (grid == 0) {
        if (n_in != 23 || out_size != NTOK * 2048 || ws_size < WS_END) { fprintf(stderr, "kernel_launch: unexpected shapes (n_in %d, out %d, ws %zu < %zu); nothing launched\n", n_in, out_size, ws_size, (size_t)WS_END); grid = -1; return; }
        int dev = 0, cus = 0, per_cu = 0;
        if (hipGetDevice(&dev) != hipSuccess || hipDeviceGetAttribute(&cus, hipDeviceAttributeMultiprocessorCount, dev) != hipSuccess) { grid = -1; return; }
        if (hipFuncSetAttribute((const void*)hybrid_fwd, hipFuncAttributeMaxDynamicSharedMemorySize, LDS_BYTES) != hipSuccess) { fprintf(stderr, "kernel_launch: hipFuncSetAttribute failed\n"); grid = -1; return; }
        if (hipOccupancyMaxActiveBlocksPerMultiprocessor(&per_cu, (const void*)hybrid_fwd, NWAVES * 64, LDS_BYTES) != hipSuccess || per_cu < 1) fprintf(stderr, "kernel_launch: occupancy query reports %d blocks per CU\n", per_cu);
        (void)hipGetLastError();
        grid = 256;
        if (grid != 256) fprintf(stderr, "kernel_launch: %d CUs; this kernel's unit maps assume 256\n", grid);
    }
    if (grid < 0) return;
    (void)hipMemsetAsync((char*)d_ws + WS_CTL, 0, CTL_ZERO_BYTES, stream);
    Args a{};
    for (int i = 0; i < 23; ++i) a.in[i] = (const float*)d_in[i];
    a.out = (float*)d_out; a.ws = (unsigned char*)d_ws;
#ifndef ONE_LAUNCH
#define ONE_LAUNCH 0
#endif
    if (ONE_LAUNCH) { a.ph_lo = 0; a.ph_hi = NPH; hipLaunchKernelGGL(hybrid_fwd, dim3(grid), dim3(NWAVES * 64), LDS_BYTES, stream, a); }
    else for (int p = 0; p < NPH; ++p) { a.ph_lo = p; a.ph_hi = p + 1; hipLaunchKernelGGL(hybrid_fwd, dim3(grid), dim3(NWAVES * 64), LDS_BYTES, stream, a); }
}
```
